# Optimizing an MI355X kernel written in HIP

```python
import math
import jax, jax.numpy as jnp
from jax import lax
import numpy as np

D_MODEL = 2048
BATCH = 4
SEQ = 2048
DEPTH = 4
DEC_BATCH = 32
DEC_SEQ = 1
PAST_LEN = 16384
PAGE_SIZE = 128

H_A = D_MODEL // 128
HD_A = 64
KV_A = H_A // 8
WINDOW = 128
ROPE_THETA = 10000.0
H_B = 4
DK_B = D_MODEL // 16
DV_B = D_MODEL // 16
H_C = 4
DK_C = D_MODEL // 32
DV_C = D_MODEL // 16
GLA_RANK = 16
GLA_NORMALIZER = 16.0
CHUNK = 64
W_A = H_A * HD_A
W_B = H_B * DV_B
W_C = H_C * DV_C
MIX = W_A + W_B + W_C
N_KEYS = 128
N_EXPERTS = N_KEYS * N_KEYS
PEER_HEADS = 8
PEER_TOPK = 16
D_QUERY = 256
D_HALF = D_QUERY // 2
PEER_BLOCK = 128
ALPHA = (2 * DEPTH) ** 0.25
BETA = (8 * DEPTH) ** -0.25
LN_EPS = 1e-5
RMS_EPS = 1e-6
MASK_VALUE = -1e30
F_FLOOR = 1e-30
VALUE_PARTS = ('v_a', 'i_b', 'v_c')

kernel_name = 'hymba_swa_hgrn2_gla_peer_step'


def _proj_layout():
    return [('q_a', W_A), ('k_a', KV_A * HD_A), ('v_a', KV_A * HD_A),
            ('q_b', H_B * DK_B), ('f_b', H_B * DK_B), ('i_b', W_B), ('g_b', W_B),
            ('q_c', H_C * DK_C), ('k_c', H_C * DK_C), ('v_c', W_C), ('g_c', W_C), ('a_c', GLA_RANK)]


def _split_points():
    sizes = [sz for _, sz in _proj_layout()]
    return [int(s) for s in np.cumsum(sizes)[:-1]]


def layer_norm(x, g, b):
    xf = x.astype(jnp.float32)
    mu = jnp.mean(xf, -1, keepdims=True)
    var = jnp.mean(jnp.square(xf - mu), -1, keepdims=True)
    return ((xf - mu) * lax.rsqrt(var + LN_EPS)).astype(x.dtype) * g + b


def rms_norm(x, w):
    xf = x.astype(jnp.float32)
    return (xf * lax.rsqrt(jnp.mean(xf * xf, -1, keepdims=True) + RMS_EPS)).astype(x.dtype) * w


def rope(x, pos):
    half = HD_A // 2
    inv = ROPE_THETA ** (-jnp.arange(half, dtype=jnp.float32) / half)
    ang = pos.astype(jnp.float32)[:, None] * inv[None, :]
    cos = jnp.cos(ang)[None, :, None, :]
    sin = jnp.sin(ang)[None, :, None, :]
    xf = x.astype(jnp.float32)
    x1, x2 = xf[..., :half], xf[..., half:]
    return jnp.concatenate([x1 * cos - x2 * sin, x2 * cos + x1 * sin], -1).astype(x.dtype)


def sink_softmax(s, valid, sink):
    s = jnp.where(valid, s, MASK_VALUE)
    m = jnp.maximum(jnp.max(s, -1, keepdims=True), sink)
    p = jnp.where(valid, jnp.exp(s - m), 0.0)
    return p / (jnp.sum(p, -1, keepdims=True) + jnp.exp(sink - m))


def window_attn_prompt(q, k, v, sinks):
    Bn, L = q.shape[:2]
    G = H_A // KV_A
    nb = L // WINDOW
    qb = q.reshape(Bn, nb, WINDOW, KV_A, G, HD_A)
    kb = k.reshape(Bn, nb, WINDOW, KV_A, HD_A)
    vb = v.reshape(Bn, nb, WINDOW, KV_A, HD_A)
    pad = ((0, 0), (1, 0), (0, 0), (0, 0), (0, 0))
    kc = jnp.concatenate([jnp.pad(kb, pad)[:, :-1], kb], axis=2)
    vc = jnp.concatenate([jnp.pad(vb, pad)[:, :-1], vb], axis=2)
    s = jnp.einsum('bnqkgd,bnskd->bnkgqs', qb, kc).astype(jnp.float32) * (HD_A ** -0.5)
    i = jnp.arange(WINDOW)[:, None]
    j = jnp.arange(2 * WINDOW)[None, :]
    diff = i + WINDOW - j
    band = (diff >= 0) & (diff <= WINDOW)
    blk = jnp.arange(nb)[:, None, None]
    valid = band[None] & ((blk > 0) | (j[None] >= WINDOW))
    sink = sinks.astype(jnp.float32).reshape(KV_A, G)[None, None, :, :, None, None]
    p = sink_softmax(s, valid[None, :, None, None], sink)
    o = jnp.einsum('bnkgqs,bnskd->bnqkgd', p.astype(v.dtype), vc)
    return o.reshape(Bn, L, H_A * HD_A)


def window_attn_sample(q, k_new, v_new, k_buf, v_buf, sinks):
    Bn, L = q.shape[:2]
    G = H_A // KV_A
    Wb = k_buf.shape[1]
    kc = jnp.concatenate([k_buf.astype(k_new.dtype), k_new], axis=1)
    vc = jnp.concatenate([v_buf.astype(v_new.dtype), v_new], axis=1)
    qg = q.reshape(Bn, L, KV_A, G, HD_A)
    s = jnp.einsum('bqkgd,bskd->bkgqs', qg, kc).astype(jnp.float32) * (HD_A ** -0.5)
    diff = jnp.arange(L)[:, None] + Wb - jnp.arange(Wb + L)[None, :]
    valid = (diff >= 0) & (diff <= WINDOW)
    sink = sinks.astype(jnp.float32).reshape(KV_A, G)[None, :, :, None, None]
    p = sink_softmax(s, valid, sink)
    o = jnp.einsum('bkgqs,bskd->bqkgd', p.astype(vc.dtype), vc).reshape(Bn, L, H_A * HD_A)
    return o, kc[:, -Wb:], vc[:, -Wb:]


def gated_recurrence(q, k, v, log_a, s0):
    Bn, L, H, dk = q.shape
    dv = v.shape[-1]
    C = math.gcd(L, CHUNK)
    n = L // C

    def chunks(t):
        return t.astype(jnp.float32).reshape(Bn, n, C, H, t.shape[-1]).transpose(1, 0, 3, 2, 4)

    causal = jnp.tril(jnp.ones((C, C), dtype=bool))[:, :, None]

    def step(S, xs):
        qc, kc, vc, ac = xs
        b = jnp.cumsum(ac, axis=2)
        o = jnp.einsum('bhtd,bhde->bhte', qc * jnp.exp(b), S)
        rel = jnp.where(causal, b[:, :, :, None, :] - b[:, :, None, :, :], 0.0)
        decay = jnp.where(causal, jnp.exp(rel), 0.0)
        att = jnp.einsum('bhtd,bhsd,bhtsd->bhts', qc, kc, decay)
        o = o + jnp.einsum('bhts,bhse->bhte', att, vc)
        b_end = b[:, :, -1:, :]
        S = jnp.exp(b_end[:, :, 0, :, None]) * S + jnp.einsum('bhsd,bhse->bhde', kc * jnp.exp(b_end - b), vc)
        return S, o

    S, o = lax.scan(step, s0.astype(jnp.float32), (chunks(q), chunks(k), chunks(v), chunks(log_a)))
    o = o.transpose(1, 0, 3, 2, 4).reshape(Bn, L, H, dv)
    return o.astype(v.dtype), S.astype(s0.dtype)


def peer(x, wq, keys, u, v):
    Bn, L, D = x.shape
    T = Bn * L
    xt = x.reshape(T, D)
    q = (xt @ wq).reshape(T, PEER_HEADS, 2, D_HALF)
    sc = jnp.einsum('thpd,hpnd->thpn', q, keys).astype(jnp.float32)
    s_top, i_top = lax.top_k(sc, PEER_TOPK)
    cand = (s_top[:, :, 0, :, None] + s_top[:, :, 1, None, :]).reshape(T, PEER_HEADS, PEER_TOPK * PEER_TOPK)
    cand_idx = (i_top[:, :, 0, :, None] * N_KEYS + i_top[:, :, 1, None, :]).reshape(T, PEER_HEADS, PEER_TOPK * PEER_TOPK)
    best, sel = lax.top_k(cand, PEER_TOPK)
    idx = jnp.take_along_axis(cand_idx, sel, axis=-1)
    gate = jax.nn.softmax(best, axis=-1)
    tb = math.gcd(T, PEER_BLOCK)
    nb = T // tb

    def block(args):
        xb, ib, gb = args
        h = jnp.einsum('td,thkd->thk', xb, jnp.take(u, ib, axis=0))
        w = (gb * jax.nn.gelu(h.astype(jnp.float32), approximate=False)).astype(xb.dtype)
        return jnp.einsum('thk,thkd->td', w, jnp.take(v, ib, axis=0))

    out = lax.map(block, (xt.reshape(nb, tb, D),
                          idx.reshape(nb, tb, PEER_HEADS, PEER_TOPK),
                          gate.reshape(nb, tb, PEER_HEADS, PEER_TOPK)))
    return out.reshape(Bn, L, D)


def trunk_layer(x, pos, p, lb, kv_buf, s_b, s_c):
    Bn, L, _ = x.shape
    proj = x @ p['w_in']
    (q_a, k_a, v_a, q_b, f_b, i_b, g_b, q_c, k_c, v_c, g_c, a_c) = jnp.split(proj, _split_points(), axis=-1)
    q_a = rope(q_a.reshape(Bn, L, H_A, HD_A), pos)
    k_a = rope(k_a.reshape(Bn, L, KV_A, HD_A), pos)
    v_a = v_a.reshape(Bn, L, KV_A, HD_A)
    if kv_buf is None:
        o_a = window_attn_prompt(q_a, k_a, v_a, p['sinks'])
        k_keep, v_keep = k_a[:, -WINDOW:], v_a[:, -WINDOW:]
    else:
        o_a, k_keep, v_keep = window_attn_sample(q_a, k_a, v_a, kv_buf[0], kv_buf[1], p['sinks'])
    if s_b is None:
        s_b = jnp.zeros((Bn, H_B, DK_B, DV_B), x.dtype)
        s_c = jnp.zeros((Bn, H_C, DK_C, DV_C), x.dtype)
    zf = f_b.astype(jnp.float32).reshape(Bn, L, H_B, DK_B)
    lbh = lb.reshape(H_B, DK_B)
    f_gate = lbh + (1.0 - lbh) * jax.nn.sigmoid(zf)
    log_f = jnp.log(jnp.maximum(f_gate, F_FLOOR))
    key_b = 1.0 - f_gate
    q_bh = jax.nn.silu(q_b.reshape(Bn, L, H_B, DK_B))
    o_b, s_b_new = gated_recurrence(q_bh, key_b, i_b.reshape(Bn, L, H_B, DV_B), log_f, s_b)
    o_b = rms_norm(o_b, p['hgrn_norm_w']).reshape(Bn, L, W_B) * jax.nn.silu(g_b)
    log_a = jax.nn.log_sigmoid((a_c @ p['gla_wa2'] + p['gla_ba']).astype(jnp.float32)) / GLA_NORMALIZER
    q_ch = q_c.reshape(Bn, L, H_C, DK_C) * (DK_C ** -0.5)
    o_c, s_c_new = gated_recurrence(q_ch, k_c.reshape(Bn, L, H_C, DK_C), v_c.reshape(Bn, L, H_C, DV_C),
                                    log_a.reshape(Bn, L, H_C, DK_C), s_c)
    o_c = rms_norm(o_c, p['gla_norm_w']).reshape(Bn, L, W_C) * jax.nn.silu(g_c)
    mix = jnp.concatenate([o_a, o_b, o_c], axis=-1) @ p['w_out']
    x = layer_norm(ALPHA * x + mix, p['ln1_g'], p['ln1_b'])
    ff = peer(x, p['peer_wq'], p['peer_keys'], p['peer_u'], p['peer_v'])
    x = layer_norm(ALPHA * x + ff, p['ln2_g'], p['ln2_b'])
    return x, k_keep, v_keep, s_b_new, s_c_new


def setup_inputs(seed: int = 0) -> dict:
    key = jax.random.key(seed)
    ks = jax.random.split(key, 24)
    f32 = jnp.float32

    def nrm(k, shape, s):
        return jax.random.normal(k, shape, f32) * s

    layout = _proj_layout()
    in_cols = sum(sz for _, sz in layout)
    col_scale = np.concatenate([np.full((sz,), BETA if name in VALUE_PARTS else 1.0, np.float32)
                                for name, sz in layout])
    win_buf = min(WINDOW, PAST_LEN)
    return {
        'x_prompt': nrm(ks[0], (BATCH, SEQ, D_MODEL), 1.0),
        'x_sample': nrm(ks[1], (DEC_BATCH, DEC_SEQ, D_MODEL), 1.0),
        'cache_k': nrm(ks[2], (DEPTH, DEC_BATCH, win_buf, KV_A, HD_A), 1.0),
        'cache_v': nrm(ks[3], (DEPTH, DEC_BATCH, win_buf, KV_A, HD_A), 1.0),
        'state_hgrn': nrm(ks[4], (DEPTH, DEC_BATCH, H_B, DK_B, DV_B), 0.5),
        'state_gla': nrm(ks[5], (DEPTH, DEC_BATCH, H_C, DK_C, DV_C), 0.5),
        'w_in': nrm(ks[6], (DEPTH, D_MODEL, in_cols), D_MODEL ** -0.5) * jnp.asarray(col_scale),
        'w_out': nrm(ks[7], (DEPTH, MIX, D_MODEL), BETA * MIX ** -0.5),
        'attn_sinks': nrm(ks[8], (DEPTH, H_A), 0.5),
        'hgrn_norm_w': 1.0 + nrm(ks[9], (DEPTH, H_B, DV_B), 0.02),
        'lb_logits': nrm(ks[10], (DEPTH, H_B * DK_B), 0.1),
        'gla_wa2': nrm(ks[11], (DEPTH, GLA_RANK, H_C * DK_C), GLA_RANK ** -0.5),
        'gla_ba': nrm(ks[12], (DEPTH, H_C * DK_C), 0.02),
        'gla_norm_w': 1.0 + nrm(ks[13], (DEPTH, H_C, DV_C), 0.02),
        'ln1_g': 1.0 + nrm(ks[14], (DEPTH, D_MODEL), 0.02),
        'ln1_b': nrm(ks[15], (DEPTH, D_MODEL), 0.02),
        'ln2_g': 1.0 + nrm(ks[16], (DEPTH, D_MODEL), 0.02),
        'ln2_b': nrm(ks[17], (DEPTH, D_MODEL), 0.02),
        'peer_wq': nrm(ks[18], (DEPTH, D_MODEL, PEER_HEADS * D_QUERY), D_MODEL ** -0.5),
        'peer_keys': nrm(ks[19], (DEPTH, PEER_HEADS, 2, N_KEYS, D_HALF), D_HALF ** -0.5),
        'peer_u': nrm(ks[20], (DEPTH, N_EXPERTS, D_MODEL), D_MODEL ** -0.5),
        'peer_v': nrm(ks[21], (DEPTH, N_EXPERTS, D_MODEL), BETA * PEER_HEADS ** -0.5),
    }


def reference(x_prompt, x_sample, cache_k, cache_v, state_hgrn, state_gla, w_in, w_out, attn_sinks,
              hgrn_norm_w, lb_logits, gla_wa2, gla_ba, gla_norm_w, ln1_g, ln1_b, ln2_g, ln2_b,
              peer_wq, peer_keys, peer_u, peer_v):
    sm = jax.nn.softmax(lb_logits.astype(jnp.float32), axis=0)
    lower = jnp.cumsum(sm, axis=0) - sm[0:1]
    pos_p = jnp.arange(x_prompt.shape[1], dtype=jnp.int32)
    pos_s = PAST_LEN + jnp.arange(x_sample.shape[1], dtype=jnp.int32)
    hp, hs = x_prompt, x_sample
    kp_l, vp_l, bp_l, cp_l, ks_l, vs_l, bs_l, cs_l = [], [], [], [], [], [], [], []
    for l in range(DEPTH):
        p = {'w_in': w_in[l], 'w_out': w_out[l], 'sinks': attn_sinks[l], 'hgrn_norm_w': hgrn_norm_w[l],
             'gla_wa2': gla_wa2[l], 'gla_ba': gla_ba[l], 'gla_norm_w': gla_norm_w[l],
             'ln1_g': ln1_g[l], 'ln1_b': ln1_b[l], 'ln2_g': ln2_g[l], 'ln2_b': ln2_b[l],
             'peer_wq': peer_wq[l], 'peer_keys': peer_keys[l], 'peer_u': peer_u[l], 'peer_v': peer_v[l]}
        hp, kp, vp, bp, cp = trunk_layer(hp, pos_p, p, lower[l], None, None, None)
        hs, ks_, vs_, bs_, cs_ = trunk_layer(hs, pos_s, p, lower[l], (cache_k[l], cache_v[l]),
                                             state_hgrn[l], state_gla[l])
        kp_l.append(kp); vp_l.append(vp); bp_l.append(bp); cp_l.append(cp)
        ks_l.append(ks_); vs_l.append(vs_); bs_l.append(bs_); cs_l.append(cs_)
    new_k_prompt = jnp.stack(kp_l)
    new_v_prompt = jnp.stack(vp_l)
    new_hgrn_prompt = jnp.stack(bp_l)
    new_gla_prompt = jnp.stack(cp_l)
    new_k_sample = jnp.stack(ks_l)
    new_v_sample = jnp.stack(vs_l)
    new_hgrn_sample = jnp.stack(bs_l)
    new_gla_sample = jnp.stack(cs_l)
    return (hp, hs, new_k_prompt, new_v_prompt, new_hgrn_prompt, new_gla_prompt,
            new_k_sample, new_v_sample, new_hgrn_sample, new_gla_sample)
```

```cpp
#include <hip/hip_runtime.h>
#include <stdint.h>

#ifndef MK_ONE_LAUNCH
#define MK_ONE_LAUNCH 1
#endif
#ifndef PEER_U_FMT
#define PEER_U_FMT 5
#endif
#ifndef PEER_V_FMT
#define PEER_V_FMT 5
#endif
#ifndef PEER_MFMA_U
#define PEER_MFMA_U 1
#endif
#ifndef PEER_F16
#define PEER_F16 1
#endif
#define REP_PRO 1
#define REP_G1 1
#define REP_G2 1
#define REP_G3 1
#define REP_MIXA 1
#define REP_MIXB 1
#define REP_PEER 1


typedef unsigned short bf16_t;
using bf16x8 = __attribute__((ext_vector_type(8))) short;
using f32x4 = __attribute__((ext_vector_type(4))) float;

constexpr int DM = 2048;
constexpr int SEQ = 2048;
constexpr int NBATCH = 4;
constexpr int TPROMPT = 8192;
constexpr int TSAMP = 32;
constexpr int TTOK = 8224;
constexpr int TPAD = 8448;
constexpr int NIN = 4880;
constexpr int NINP = 5120;
constexpr int NEXP = 16384;
constexpr int NTHREADS = 512;
constexpr float ALPHA_F = 1.681792830507429f;

constexpr int C_QA = 0, C_KA = 1024, C_VA = 1152, C_QB = 1280, C_FB = 1792, C_IB = 2304, C_GB = 2816;
constexpr int C_QC = 3328, C_KC = 3584, C_VC = 3840, C_GC = 4352, C_AC = 4864;

constexpr long O_YP = 0;
constexpr long O_YS = O_YP + 16777216L;
constexpr long O_KP = O_YS + 65536L;
constexpr long O_VP = O_KP + 262144L;
constexpr long O_HP = O_VP + 262144L;
constexpr long O_GP = O_HP + 1048576L;
constexpr long O_KS = O_GP + 524288L;
constexpr long O_VS = O_KS + 2097152L;
constexpr long O_HS = O_VS + 2097152L;
constexpr long O_GS = O_HS + 8388608L;

constexpr int LDS_MAIN = 163776 - 0;
constexpr int LDS_BYTES = LDS_MAIN + 64;

struct Params {
    const float *x_prompt, *x_sample, *cache_k, *cache_v, *state_hgrn, *state_gla, *w_in, *w_out, *sinks, *hgrn_nw,
        *lb_logits, *gla_wa2, *gla_ba, *gla_nw, *ln1_g, *ln1_b, *ln2_g, *ln2_b, *peer_wq, *peer_keys, *peer_u, *peer_v;
    float* out;
    unsigned* bar;
    bf16_t *wt_in, *wt_out, *wt_q, *keys;
    unsigned char *U8, *V8;
    float *Usc, *Vsc;
    float *rope_cos, *rope_sin;
    float* Xf; bf16_t* Xbf; bf16_t* PROJ; bf16_t* OCAT; float* Z1; float* X1f; bf16_t* X1bf; bf16_t* Q; float* SC;
    bf16_t *HST, *GST;
    float *HD, *GD;
    bf16_t* LFC;
    float* ZS;
    float *C1, *C2;
    float *CP1, *CP2;
};

__device__ __forceinline__ float bf2f(bf16_t h) { return __uint_as_float(((unsigned)h) << 16); }
__device__ __forceinline__ bf16_t f2bf(float f) { __bf16 b = (__bf16)f; return __builtin_bit_cast(unsigned short, b); }
__device__ __forceinline__ unsigned pack2(float a, float b) { return (unsigned)f2bf(a) | ((unsigned)f2bf(b) << 16); }
__device__ __forceinline__ void unpack8(const uint4 v, float* f) {
    f[0] = __uint_as_float(v.x << 16); f[1] = __uint_as_float(v.x & 0xffff0000u);
    f[2] = __uint_as_float(v.y << 16); f[3] = __uint_as_float(v.y & 0xffff0000u);
    f[4] = __uint_as_float(v.z << 16); f[5] = __uint_as_float(v.z & 0xffff0000u);
    f[6] = __uint_as_float(v.w << 16); f[7] = __uint_as_float(v.w & 0xffff0000u);
}
__device__ __forceinline__ uint4 pack8(const float* f) {
    uint4 v; v.x = pack2(f[0], f[1]); v.y = pack2(f[2], f[3]); v.z = pack2(f[4], f[5]); v.w = pack2(f[6], f[7]); return v;
}

__device__ __forceinline__ void wave_lds_fence() {
    __builtin_amdgcn_fence(__ATOMIC_RELEASE, "wavefront");
    __builtin_amdgcn_wave_barrier();
    __builtin_amdgcn_fence(__ATOMIC_ACQUIRE, "wavefront");
}
template <int CTRL> __device__ __forceinline__ float dpp_mov(float v) {
    return __int_as_float(__builtin_amdgcn_update_dpp(__float_as_int(v), __float_as_int(v), CTRL, 0xf, 0xf, false));
}
__device__ __forceinline__ float row16_max(float v) {
    v = fmaxf(v, dpp_mov<0xB1>(v)); v = fmaxf(v, dpp_mov<0x4E>(v)); v = fmaxf(v, dpp_mov<0x141>(v)); v = fmaxf(v, dpp_mov<0x140>(v));
    return v;
}
__device__ __forceinline__ float row16_sum(float v) {
    v = v + dpp_mov<0xB1>(v); v = v + dpp_mov<0x4E>(v); v = v + dpp_mov<0x141>(v); v = v + dpp_mov<0x140>(v);
    return v;
}
__device__ __forceinline__ float rdlane(float v, int l) { return __int_as_float(__builtin_amdgcn_readlane(__float_as_int(v), l)); }
__device__ __forceinline__ float wave_max(float v) {
    v = row16_max(v);
    return fmaxf(fmaxf(rdlane(v, 0), rdlane(v, 16)), fmaxf(rdlane(v, 32), rdlane(v, 48)));
}
__device__ __forceinline__ float wave_sum(float v) {
    v = row16_sum(v);
    return (rdlane(v, 0) + rdlane(v, 16)) + (rdlane(v, 32) + rdlane(v, 48));
}
template <int CTRL> __device__ __forceinline__ unsigned dpp_mov_u(unsigned v) {
    return (unsigned)__builtin_amdgcn_update_dpp((int)v, (int)v, CTRL, 0xf, 0xf, false);
}
__device__ __forceinline__ unsigned umax_(unsigned a, unsigned b) { return a > b ? a : b; }
__device__ __forceinline__ unsigned wave_max_u32(unsigned v) {
    v = umax_(v, dpp_mov_u<0xB1>(v)); v = umax_(v, dpp_mov_u<0x4E>(v)); v = umax_(v, dpp_mov_u<0x141>(v)); v = umax_(v, dpp_mov_u<0x140>(v));
    const unsigned a = (unsigned)__builtin_amdgcn_readlane((int)v, 0), b = (unsigned)__builtin_amdgcn_readlane((int)v, 16);
    const unsigned c = (unsigned)__builtin_amdgcn_readlane((int)v, 32), d = (unsigned)__builtin_amdgcn_readlane((int)v, 48);
    return umax_(umax_(a, b), umax_(c, d));
}
__device__ __forceinline__ f32x4 mfma16(bf16x8 a, bf16x8 b, f32x4 c) { return __builtin_amdgcn_mfma_f32_16x16x32_bf16(a, b, c, 0, 0, 0); }
__device__ __forceinline__ bf16x8 ldfrag(const bf16_t* base, int stride, int row0, int k0, int lane) {
    return *reinterpret_cast<const bf16x8*>(base + (row0 + (lane & 15)) * stride + k0 + (lane >> 4) * 8);
}
__device__ __forceinline__ float sigmoidf_(float x) { return __builtin_amdgcn_rcpf(1.f + __expf(-x)); }
__device__ __forceinline__ float siluf_(float x) { return x * __builtin_amdgcn_rcpf(1.f + __expf(-x)); }
__device__ __forceinline__ float logsigmoidf_(float x) { return fminf(x, 0.f) - __logf(1.f + __expf(-fabsf(x))); }
__device__ __forceinline__ float geluf_(float x) { return 0.5f * x * (1.f + erff(x * 0.7071067811865476f)); }

__device__ __forceinline__ float hgrn_lower(const float* lb, int l, int col) {
    if (l == 0) return 0.f;
    float a0 = lb[col], a1 = lb[512 + col], a2 = lb[1024 + col], a3 = lb[1536 + col];
    float mx = fmaxf(fmaxf(a0, a1), fmaxf(a2, a3));
    float e0 = __expf(a0 - mx), e1 = __expf(a1 - mx), e2 = __expf(a2 - mx), e3 = __expf(a3 - mx);
    float inv = 1.f / (e0 + e1 + e2 + e3);
    float s = e1; if (l >= 2) s += e2; if (l >= 3) s += e3;
    return s * inv;
}

__device__ __forceinline__ int otid() { int t = threadIdx.x; asm volatile("" : "+v"(t)); return t; }

#define XB_TMO      128
#define XB_XCNT(j)  (256  + 64 * (j))
#define XB_XSUB(j)  (1280 + 64 * (j))
#define XB_XGEN(j)  (2304 + 64 * (j))
#define XB_TOP      3328
#define XB_TOPGEN   3392
#define XCD_BAR_WORDS 3456
#define XB_SPIN_CAP (1u << 22)
#define LAS __attribute__((address_space(3)))

__device__ __forceinline__ unsigned xb_ld(unsigned* p)              { return __hip_atomic_load(p, __ATOMIC_RELAXED, __HIP_MEMORY_SCOPE_AGENT); }
__device__ __forceinline__ unsigned xb_add(unsigned* p, unsigned v) { return __hip_atomic_fetch_add(p, v, __ATOMIC_RELAXED, __HIP_MEMORY_SCOPE_AGENT); }
__device__ __forceinline__ unsigned xb_xcc_id() { return (unsigned)__builtin_amdgcn_s_getreg((3 << 11) | 20) & 0xFu; }
#define XB_SPIN(cond, bar) do { unsigned _sp = 0; while (cond) { __builtin_amdgcn_s_sleep(1); \
    if ((++_sp & 255u) == 0u) { if (xb_ld(&(bar)[XB_TMO])) break; if (_sp > XB_SPIN_CAP) { atomicAdd(&(bar)[XB_TMO], 1u); break; } } } } while (0)

struct XcdBarrier {
    unsigned* bar; unsigned x;
    volatile LAS unsigned* st;
};
__device__ __forceinline__ XcdBarrier xcd_barrier_post(unsigned* bar, volatile LAS unsigned* st) {
    XcdBarrier b; b.bar = bar; b.x = xb_xcc_id(); b.st = st;
    if (threadIdx.x == 0) (void)xb_add(&bar[XB_XCNT(b.x)], 1u);
    return b;
}
__device__ __forceinline__ void xcd_barrier_complete(unsigned* bar, unsigned x, unsigned& nloc, unsigned& nx) {
    const unsigned G = gridDim.x * gridDim.y * gridDim.z;
    unsigned sum, cnt, mine, sp = 0u;
    for (;;) {
        sum = 0u; cnt = 0u; mine = 0u;
#pragma unroll
        for (unsigned j = 0; j < 16; ++j) { const unsigned c = xb_ld(&bar[XB_XCNT(j)]); sum += c; cnt += (c > 0u) ? 1u : 0u; mine = (j == x) ? c : mine; }
        if (sum == G) break;
        __builtin_amdgcn_s_sleep(1);
        if ((++sp & 255u) == 0u) { if (xb_ld(&bar[XB_TMO])) break; if (sp > XB_SPIN_CAP) { atomicAdd(&bar[XB_TMO], 1u); break; } }
    }
    nloc = mine > 0u ? mine : 1u; nx = cnt > 0u ? cnt : 1u;
}
__device__ __forceinline__ void xcd_barrier(const XcdBarrier& b) {
    asm volatile("s_waitcnt vmcnt(0)" ::: "memory");
    __syncthreads();
    if (threadIdx.x == 0) {
        unsigned* bar = b.bar;
        __builtin_amdgcn_s_waitcnt(0);
        const unsigned bx = xb_xcc_id();
        unsigned nloc = b.st[0], nx = b.st[1];
        if (nloc == 0u) { xcd_barrier_complete(bar, bx, nloc, nx); b.st[0] = nloc; b.st[1] = nx; }
        const unsigned old = xb_add(&bar[XB_XSUB(bx)], 1u);
        const unsigned gen = old / nloc;
        if (old + 1u == (gen + 1u) * nloc) {
            __builtin_amdgcn_fence(__ATOMIC_RELEASE, "agent");
            asm volatile("s_waitcnt vmcnt(0)" ::: "memory");
            const unsigned og = xb_add(&bar[XB_TOP], 1u);
            const unsigned tg = og / nx;
            if (og + 1u == (tg + 1u) * nx) xb_add(&bar[XB_TOPGEN], 1u);
            else XB_SPIN(xb_ld(&bar[XB_TOPGEN]) == tg, bar);
            __builtin_amdgcn_fence(__ATOMIC_ACQUIRE, "agent");
            xb_add(&bar[XB_XGEN(bx)], 1u);
            asm volatile("s_waitcnt vmcnt(0)" ::: "memory");
        } else {
            XB_SPIN(xb_ld(&bar[XB_XGEN(bx)]) == gen, bar);
            __builtin_amdgcn_fence(__ATOMIC_ACQUIRE, "agent");
            asm volatile("s_waitcnt vmcnt(0)" ::: "memory");
        }
    }
    __syncthreads();
}

__device__ __forceinline__ void conv_elem(const float* __restrict__ src, bf16_t* __restrict__ dst, long n, long gtid, long gsz) {
    for (long i = gtid * 8; i < n; i += gsz * 8) {
        float4 a = *reinterpret_cast<const float4*>(src + i);
        float4 b = *reinterpret_cast<const float4*>(src + i + 4);
        uint4 v; v.x = pack2(a.x, a.y); v.y = pack2(a.z, a.w); v.z = pack2(b.x, b.y); v.w = pack2(b.z, b.w);
        *reinterpret_cast<uint4*>(dst + i) = v;
    }
}
__device__ __forceinline__ void conv_rows_fp8(const float* __restrict__ src, unsigned char* __restrict__ dst, float* __restrict__ scl, int nrows) {
    const int tid = otid(), lane = tid & 63;
    const int gw = blockIdx.x * 8 + (tid >> 6), nw = gridDim.x * 8;
    for (int r = gw * 2; r < nrows; r += nw * 2) {
        float v[2][32];
#pragma unroll
        for (int rr = 0; rr < 2; ++rr)
#pragma unroll
            for (int i = 0; i < 2; ++i)
#pragma unroll
                for (int q = 0; q < 4; ++q) {
                    const float4 a = *reinterpret_cast<const float4*>(src + (long)(r + rr) * DM + i * 1024 + lane * 16 + q * 4);
                    v[rr][i * 16 + q * 4] = a.x; v[rr][i * 16 + q * 4 + 1] = a.y; v[rr][i * 16 + q * 4 + 2] = a.z; v[rr][i * 16 + q * 4 + 3] = a.w;
                }
#pragma unroll
        for (int rr = 0; rr < 2; ++rr) {
            float am = 0.f;
#pragma unroll
            for (int i = 0; i < 32; ++i) am = fmaxf(am, fabsf(v[rr][i]));
            am = wave_max(am);
            const float sc = am > 0.f ? 448.f / am : 1.f;
            if (lane == 0) scl[r + rr] = am > 0.f ? am * (1.f / 448.f) : 1.f;
#pragma unroll
            for (int i = 0; i < 2; ++i) {
                unsigned o[4];
#pragma unroll
                for (int q = 0; q < 4; ++q) {
                    int pk = __builtin_amdgcn_cvt_pk_fp8_f32(v[rr][i * 16 + q * 4] * sc, v[rr][i * 16 + q * 4 + 1] * sc, 0, false);
                    pk = __builtin_amdgcn_cvt_pk_fp8_f32(v[rr][i * 16 + q * 4 + 2] * sc, v[rr][i * 16 + q * 4 + 3] * sc, pk, true);
                    o[q] = (unsigned)pk;
                }
                *reinterpret_cast<uint4*>(dst + (long)(r + rr) * DM + i * 1024 + lane * 16) = make_uint4(o[0], o[1], o[2], o[3]);
            }
        }
    }
}
__device__ __forceinline__ void conv_rows_fp4(const float* __restrict__ src, unsigned char* __restrict__ dst, int nrows) {
    const int tid = otid(), lane = tid & 63;
    const int gw = blockIdx.x * 8 + (tid >> 6), nw = gridDim.x * 8;
    for (int r = gw * 2; r < nrows; r += nw * 2) {
        float v[2][32];
#pragma unroll
        for (int rr = 0; rr < 2; ++rr)
#pragma unroll
            for (int q = 0; q < 8; ++q) {
                const float4 a = *reinterpret_cast<const float4*>(src + (long)(r + rr) * DM + lane * 32 + q * 4);
                v[rr][q * 4] = a.x; v[rr][q * 4 + 1] = a.y; v[rr][q * 4 + 2] = a.z; v[rr][q * 4 + 3] = a.w;
            }
#pragma unroll
        for (int rr = 0; rr < 2; ++rr) {
            float am = 0.f;
#pragma unroll
            for (int i = 0; i < 32; ++i) am = fmaxf(am, fabsf(v[rr][i]));
            int e = 0;
            if (am > 0.f) { const float m = frexpf(am * (1.f / 6.f), &e); if (m == 0.5f) e -= 1; }
            e = e < -126 ? -126 : (e > 126 ? 126 : e);
            const float inv = __uint_as_float((unsigned)(127 - e) << 23);
            unsigned o[4];
#pragma unroll
            for (int w = 0; w < 4; ++w) {
                unsigned pk = 0u;
                pk = __builtin_amdgcn_cvt_scalef32_pk_fp4_f32(pk, v[rr][w * 8 + 0] * inv, v[rr][w * 8 + 1] * inv, 1.0f, 0);
                pk = __builtin_amdgcn_cvt_scalef32_pk_fp4_f32(pk, v[rr][w * 8 + 2] * inv, v[rr][w * 8 + 3] * inv, 1.0f, 1);
                pk = __builtin_amdgcn_cvt_scalef32_pk_fp4_f32(pk, v[rr][w * 8 + 4] * inv, v[rr][w * 8 + 5] * inv, 1.0f, 2);
                pk = __builtin_amdgcn_cvt_scalef32_pk_fp4_f32(pk, v[rr][w * 8 + 6] * inv, v[rr][w * 8 + 7] * inv, 1.0f, 3);
                o[w] = pk;
            }
            unsigned char* drow = dst + (long)(r + rr) * 1088;
            *reinterpret_cast<uint4*>(drow + lane * 16) = make_uint4(o[0], o[1], o[2], o[3]);
            drow[1024 + lane] = (unsigned char)(e + 127);
        }
    }
}
__device__ __forceinline__ void conv_rows_fp4r(const float* __restrict__ src, unsigned char* __restrict__ dst, float* __restrict__ scl, int nrows) {
    const int tid = otid(), lane = tid & 63;
    const int gw = blockIdx.x * 8 + (tid >> 6), nw = gridDim.x * 8;
    typedef float f4 __attribute__((ext_vector_type(4)));
    f4 cur[2][8], nxt[2][8];
    auto issue = [&](f4 (&buf)[2][8], int r) {
#pragma unroll
        for (int rr = 0; rr < 2; ++rr)
#pragma unroll
            for (int q = 0; q < 8; ++q)
                buf[rr][q] = *reinterpret_cast<const f4*>(src + (long)(r + rr) * DM + lane * 32 + q * 4);
    };
    int r = gw * 2;
    if (r < nrows) issue(cur, r);
    for (; r < nrows; r += nw * 2) {
        const int rn = r + nw * 2;
        if (rn < nrows) issue(nxt, rn);
#pragma unroll
        for (int rr = 0; rr < 2; ++rr) {
            float am = 0.f;
#pragma unroll
            for (int q = 0; q < 8; ++q) am = fmaxf(am, fmaxf(fmaxf(fabsf(cur[rr][q].x), fabsf(cur[rr][q].y)), fmaxf(fabsf(cur[rr][q].z), fabsf(cur[rr][q].w))));
            am = wave_max(am);
            const float sc = am > 0.f ? 6.f / am : 1.f;
            if (lane == 0) scl[r + rr] = am > 0.f ? am * (1.f / 6.f) : 1.f;
            unsigned o[4];
#pragma unroll
            for (int w = 0; w < 4; ++w) {
                unsigned pk = 0u;
                pk = __builtin_amdgcn_cvt_scalef32_pk_fp4_f32(pk, cur[rr][2 * w].x * sc, cur[rr][2 * w].y * sc, 1.0f, 0);
                pk = __builtin_amdgcn_cvt_scalef32_pk_fp4_f32(pk, cur[rr][2 * w].z * sc, cur[rr][2 * w].w * sc, 1.0f, 1);
                pk = __builtin_amdgcn_cvt_scalef32_pk_fp4_f32(pk, cur[rr][2 * w + 1].x * sc, cur[rr][2 * w + 1].y * sc, 1.0f, 2);
                pk = __builtin_amdgcn_cvt_scalef32_pk_fp4_f32(pk, cur[rr][2 * w + 1].z * sc, cur[rr][2 * w + 1].w * sc, 1.0f, 3);
                o[w] = pk;
            }
            *reinterpret_cast<uint4*>(dst + (long)(r + rr) * 1024 + lane * 16) = make_uint4(o[0], o[1], o[2], o[3]);
        }
#pragma unroll
        for (int rr = 0; rr < 2; ++rr)
#pragma unroll
            for (int q = 0; q < 8; ++q) cur[rr][q] = nxt[rr][q];
    }
}
__device__ __forceinline__ void transpose_conv(const float* __restrict__ W, int K, int N, int NP, bf16_t* __restrict__ Wt, int layer0, int nlayers,
                                               int bfirst, int nblk,
                                               const float* __restrict__ gain = nullptr, const float* __restrict__ bias = nullptr,
                                               float* __restrict__ c1 = nullptr, float* __restrict__ c2 = nullptr) {
    extern __shared__ __attribute__((aligned(16))) char smem[];
    float* tile = reinterpret_cast<float*>(smem);
    const int tid = otid();
    const int nkt = K / 64, nnt = NP / 256, items = nlayers * nkt * nnt;
    if ((int)blockIdx.x < bfirst || (int)blockIdx.x >= bfirst + nblk) return;
    for (int it = (int)blockIdx.x - bfirst; it < items; it += nblk) {
        const int l = layer0 + it / (nkt * nnt), r = it % (nkt * nnt), kt = r / nnt, nt = r % nnt;
        const float* Wl = W + (long)l * K * N;
        bf16_t* Wtl = Wt + (long)l * NP * K;
        {
            const int kk = tid >> 3, c0 = (tid & 7) * 4;
            float4 v[8];
#pragma unroll
            for (int i = 0; i < 8; ++i) {
                const int n = nt * 256 + c0 + i * 32;
                v[i] = (n < N) ? *reinterpret_cast<const float4*>(Wl + (long)(kt * 64 + kk) * N + n) : make_float4(0.f, 0.f, 0.f, 0.f);
            }
            float gk = 1.f, bk = 0.f;
            if (gain != nullptr) { gk = gain[l * K + kt * 64 + kk]; bk = bias[l * K + kt * 64 + kk]; }
#pragma unroll
            for (int i = 0; i < 8; ++i) {
                float* tp = tile + kk * 257 + c0 + i * 32;
                tp[0] = v[i].x; tp[1] = v[i].y; tp[2] = v[i].z; tp[3] = v[i].w;
            }
            (void)gk; (void)bk;
        }
        __syncthreads();
        {
            const int nn = tid & 255, kh = tid >> 8;
            float vals[32];
#pragma unroll
            for (int i = 0; i < 32; ++i) vals[i] = tile[(kh * 32 + i) * 257 + nn];
            float s1 = 0.f, s2 = 0.f;
            if (gain != nullptr) {
#pragma unroll
                for (int i = 0; i < 32; ++i) {
                    const float raw = vals[i];
                    vals[i] = bf2f(f2bf(raw * gain[l * K + kt * 64 + kh * 32 + i]));
                    s1 += vals[i]; s2 += raw * bias[l * K + kt * 64 + kh * 32 + i];
                }
            }
            bf16_t* dst = Wtl + (long)(nt * 256 + nn) * K + kt * 64 + kh * 32;
#pragma unroll
            for (int i = 0; i < 4; ++i) *reinterpret_cast<uint4*>(dst + i * 8) = pack8(vals + i * 8);
            if (gain != nullptr) {
                __syncthreads();
                float* ps = tile;
                ps[(kh * 256 + nn) * 2] = s1; ps[(kh * 256 + nn) * 2 + 1] = s2;
                __syncthreads();
                if (tid < 256) {
                    c1[((long)l * nkt + kt) * NP + nt * 256 + tid] = ps[tid * 2] + ps[(256 + tid) * 2];
                    c2[((long)l * nkt + kt) * NP + nt * 256 + tid] = ps[tid * 2 + 1] + ps[(256 + tid) * 2 + 1];
                }
            }
        }
        __syncthreads();
    }
}
__device__ __forceinline__ void ph_prologue(const Params& p) {
    const int tid = otid();
    const long gtid = (long)blockIdx.x * 512 + tid, gsz = (long)gridDim.x * 512;
    if (PEER_U_FMT == 8) conv_rows_fp8(p.peer_u, p.U8, p.Usc, 4 * NEXP); else if (PEER_U_FMT == 5) conv_rows_fp4r(p.peer_u, p.U8, p.Usc, 4 * NEXP); else conv_rows_fp4(p.peer_u, p.U8, 4 * NEXP);
    if (PEER_V_FMT == 8) conv_rows_fp8(p.peer_v, p.V8, p.Vsc, 4 * NEXP); else if (PEER_V_FMT == 5) conv_rows_fp4r(p.peer_v, p.V8, p.Vsc, 4 * NEXP); else conv_rows_fp4(p.peer_v, p.V8, 4 * NEXP);
    conv_elem(p.peer_keys, p.keys, 4L * 16 * 128 * 128, gtid, gsz);
    transpose_conv(p.w_in, DM, NIN, NINP, p.wt_in, 0, 1, 0, gridDim.x);
    transpose_conv(p.w_out, DM, DM, DM, p.wt_out, 0, 1, 0, gridDim.x);
    transpose_conv(p.peer_wq, DM, DM, DM, p.wt_q, 0, 1, 0, gridDim.x, p.ln1_g, p.ln1_b, p.CP1, p.CP2);
    for (long i = gtid; i < 2049L * 32; i += gsz) {
        const int pi = (int)(i >> 5), fi = (int)(i & 31);
        const double pos = (pi < 2048) ? (double)pi : 16384.0;
        const double inv = pow(10000.0, -(double)fi / 32.0);
        const double ang = pos * inv;
        p.rope_cos[i] = (float)cos(ang);
        p.rope_sin[i] = (float)sin(ang);
    }
    {
        const long total = (long)TPAD * DM, step = gsz * 4;
        for (long i0 = gtid * 4; i0 < total; i0 += step * 4) {
            float4 v[4]; unsigned m[4];
#pragma unroll
            for (int k = 0; k < 4; ++k) {
                long i = i0 + k * step; if (i >= total) i = i0;
                const long row = i / DM; const int col = (int)(i % DM);
                const float* src = (row < TPROMPT) ? (p.x_prompt + row * DM + col)
                                                   : (p.x_sample + ((row < TTOK ? row : (long)TTOK - 1) - TPROMPT) * DM + col);
                v[k] = *reinterpret_cast<const float4*>(src);
                m[k] = (row < TTOK) ? 0xffffffffu : 0u;
            }
#pragma unroll
            for (int k = 0; k < 4; ++k) {
                const long i = i0 + k * step;
                if (i < total) {
                    uint2 b; b.x = pack2(v[k].x, v[k].y) & m[k]; b.y = pack2(v[k].z, v[k].w) & m[k];
                    *reinterpret_cast<uint2*>(p.Xbf + i) = b;
                }
            }
        }
    }
    for (long i = gtid; i < (long)(TPAD - TTOK) * DM; i += gsz) {
        p.OCAT[(long)TTOK * DM + i] = 0;
        p.X1bf[(long)TTOK * DM + i] = 0;
    }
}

constexpr int BM = 256, BK = 64, HALF = 128, NXCD = 8, WGM = 8, HT = HALF * BK;

__device__ __forceinline__ int lds_byte(int r, int c) {
    int st = (r >> 4) * 2 + (c >> 5), rr = r & 15, cc = c & 31, ob = rr * 64 + cc * 2;
    return st * 1024 + (ob ^ (((ob >> 9) & 1) << 5));
}
__device__ __forceinline__ void stage_rc(int b, int& R, int& C) {
    int st = b / 1024, sb = b % 1024, swz = sb ^ (((sb >> 9) & 1) << 5);
    R = (st >> 1) * 16 + swz / 64; C = (st & 1) * 32 + (swz % 64) / 2;
}

enum { EPI_BF16 = 0, EPI_RESID = 1, EPI_PROJ = 2, EPI_SCORES = 3 };
struct ProjEpi { const float *rope_cos, *rope_sin, *lb, *wa2, *ba; float* out; int l; const bf16_t* keys; float* zs; const float *c1, *c2; const bf16_t* zb; bf16_t* scb; };


template <int EPI>
__device__ __forceinline__ void skinny_item(const bf16_t* __restrict__ A, const bf16_t* __restrict__ Bt, int N, int K, int n0,
                                            bf16_t* __restrict__ Cb, float* __restrict__ Cf, const bf16_t* __restrict__ R, float alpha, const ProjEpi pe);

template <int EPI>
__device__ __forceinline__ void gemm_phase(const bf16_t* __restrict__ A, const bf16_t* __restrict__ Bt, int M, int N, int K,
                           bf16_t* __restrict__ Cb, float* __restrict__ Cf, const bf16_t* __restrict__ R, float alpha, const ProjEpi pe) {
    extern __shared__ __attribute__((aligned(16))) char smem[];
    bf16_t* shm = reinterpret_cast<bf16_t*>(smem);
#define SA(b, h) (shm + ((b) * 2 + (h)) * HT)
#define SB(b, h) (shm + (4 + (b) * 2 + (h)) * HT)
#define STAGE_X(T, P, BASE, br, kt) do { long _g = (long)(br) * K + (long)(kt) * BK; \
    for (int _i = 0; _i < 2; ++_i) { int _b = (T) * 16 + _i * 8192; int _r, _c; stage_rc(_b, _r, _c); \
      __builtin_amdgcn_global_load_lds((const unsigned*)(BASE + _g + (long)_r * K + _c), \
        (unsigned*)((char*)(P) + _b), 16, 0, 0); } } while (0)
#define STAGE(P, BASE, br, kt) STAGE_X(tx, P, BASE, br, kt)
#define LDA(dst, b, h) for (int m = 0; m < 4; ++m) for (int k = 0; k < 2; ++k) \
    dst[m][k] = *reinterpret_cast<const bf16x8*>((char*)SA(b, h) + lds_byte(wr * 64 + m * 16 + fr, k * 32 + fq * 8))
#define LDB(dst, b, h) for (int n = 0; n < 2; ++n) for (int k = 0; k < 2; ++k) \
    dst[n][k] = *reinterpret_cast<const bf16x8*>((char*)SB(b, h) + lds_byte(wc * 32 + n * 16 + fr, k * 32 + fq * 8))
#define MMA(ai, bj, At_, Bt_) do { __builtin_amdgcn_s_setprio(1); \
    for (int m = 0; m < 4; ++m) for (int n = 0; n < 2; ++n) for (int k = 0; k < 2; ++k) \
      acc[ai][bj][m][n] = __builtin_amdgcn_mfma_f32_16x16x32_bf16(At_[m][k], Bt_[n][k], acc[ai][bj][m][n], 0, 0, 0); \
    __builtin_amdgcn_s_setprio(0); } while (0)
#define WAIT_V(n) asm volatile("s_waitcnt vmcnt(" #n ")" ::: "memory")
#define WAIT_L(n) asm volatile("s_waitcnt lgkmcnt(" #n ")" ::: "memory")
#define BAR __builtin_amdgcn_s_barrier()
#define SCHED __builtin_amdgcn_sched_barrier(0)

    const int nM = M / BM, nN = N / BM, nwg = nM * nN;
    const int nt = K / BK;
    for (int tile = blockIdx.x; tile < nwg; tile += gridDim.x) {
        int wgid = tile;
        { int q = nwg / NXCD, r = nwg % NXCD, xcd = wgid % NXCD, off = wgid / NXCD;
          wgid = (xcd < r ? xcd * (q + 1) : r * (q + 1) + (xcd - r) * q) + off; }
        int nig = WGM * nN, gid = wgid / nig, fm = gid * WGM, gsz = min(nM - fm, WGM);
        int pm = fm + ((wgid % nig) % gsz), pn = (wgid % nig) / gsz, brow = pm * BM, bcol = pn * BM;
        int tx = otid(); asm volatile("" : "+v"(tx)); int wid = tx >> 6, lane = tx & 63, wr = wid >> 2, wc = wid & 3, fr = lane & 15, fq = lane >> 4;
        f32x4 acc[2][2][4][2] = {};
        bf16x8 At[4][2], B0[2][2], B1[2][2];
        STAGE(SB(0, 0), Bt, bcol, 0); STAGE(SA(0, 0), A, brow, 0);
        STAGE(SB(0, 1), Bt, bcol + HALF, 0); STAGE(SA(0, 1), A, brow + HALF, 0);
        if (wr == 1) BAR;
        WAIT_V(4); BAR;
        STAGE(SB(1, 0), Bt, bcol, 1); STAGE(SA(1, 0), A, brow, 1); STAGE(SB(1, 1), Bt, bcol + HALF, 1);
        WAIT_V(6); BAR;
        for (int t = 0; t < nt - 2; t += 2) {
            LDB(B0, 0, 0); SCHED; LDA(At, 0, 0); STAGE(SA(1, 1), A, brow + HALF, t + 1);
            WAIT_L(8); BAR; WAIT_L(0); MMA(0, 0, At, B0); BAR; SCHED;
            LDB(B1, 0, 1); STAGE(SB(0, 0), Bt, bcol, t + 2);
            BAR; WAIT_L(0); MMA(0, 1, At, B1); BAR;
            LDA(At, 0, 1); STAGE(SA(0, 0), A, brow, t + 2);
            BAR; WAIT_L(0); MMA(1, 0, At, B0); BAR; SCHED;
            STAGE(SB(0, 1), Bt, bcol + HALF, t + 2);
            WAIT_V(6); BAR; MMA(1, 1, At, B1); BAR;
            LDB(B0, 1, 0); SCHED; LDA(At, 1, 0); STAGE(SA(0, 1), A, brow + HALF, t + 2);
            WAIT_L(8); BAR; WAIT_L(0); MMA(0, 0, At, B0); BAR; SCHED;
            LDB(B1, 1, 1); STAGE(SB(1, 0), Bt, bcol, t + 3);
            BAR; WAIT_L(0); MMA(0, 1, At, B1); BAR;
            LDA(At, 1, 1); STAGE(SA(1, 0), A, brow, t + 3);
            BAR; WAIT_L(0); MMA(1, 0, At, B0); BAR; SCHED;
            STAGE(SB(1, 1), Bt, bcol + HALF, t + 3);
            WAIT_V(6); BAR; MMA(1, 1, At, B1); BAR;
        }
        int tz = otid(); asm volatile("" : "+v"(tz)); wid = tz >> 6; lane = tz & 63; wr = wid >> 2; wc = wid & 3; fr = lane & 15; fq = lane >> 4;
        { LDB(B0, 0, 0); WAIT_V(0); LDA(At, 0, 0); STAGE_X(tz, SA(1, 1), A, brow + HALF, nt - 1);
          BAR; WAIT_L(0); MMA(0, 0, At, B0); BAR;
          LDB(B1, 0, 1); BAR; WAIT_L(0); MMA(0, 1, At, B1); BAR;
          LDA(At, 0, 1); WAIT_V(4); BAR; WAIT_L(0); MMA(1, 0, At, B0); MMA(1, 1, At, B1); BAR; }
        { LDB(B0, 1, 0); LDA(At, 1, 0); WAIT_V(2); BAR; WAIT_L(0); MMA(0, 0, At, B0); BAR;
          LDB(B1, 1, 1); WAIT_V(0); BAR; WAIT_L(0); MMA(0, 1, At, B1); BAR;
          LDA(At, 1, 1); BAR; WAIT_L(0); MMA(1, 0, At, B0); MMA(1, 1, At, B1); BAR; }
        if (wr == 0) BAR;
        __syncthreads();
        if (EPI == EPI_SCORES) {
            bf16_t* Qs = reinterpret_cast<bf16_t*>(smem);
            bf16_t* Kk = Qs + 256 * 136;
            float* rst = reinterpret_cast<float*>(Kk + 128 * 136);
            const int w8 = tz >> 6;
            if (tz < 256) {
                float s1 = 0.f, s2 = 0.f;
#pragma unroll
                for (int q = 0; q < 8; ++q) { const float2 pq = *reinterpret_cast<const float2*>(pe.zs + ((long)(brow + tz) * 8 + q) * 2); s1 += pq.x; s2 += pq.y; }
                const float mean = s1 * (1.f / DM);
                rst[tz * 2] = mean; rst[tz * 2 + 1] = rsqrtf(fmaxf(s2 * (1.f / DM) - mean * mean, 0.f) + 1e-5f);
            }
            __syncthreads();
#pragma unroll
            for (int bj = 0; bj < 2; ++bj) {
                const int jb = (bcol >> 7) + bj;
                uint4 kpre[4];
#pragma unroll
                for (int i = 0; i < 4; ++i) {
                    const int idx = tz + i * 512, row = idx >> 4, c8 = idx & 15;
                    kpre[i] = *reinterpret_cast<const uint4*>(pe.keys + ((long)jb * 128 + row) * 128 + c8 * 8);
                }
                float c1v[2], c2v[2];
#pragma unroll
                for (int n = 0; n < 2; ++n) { const int cg = bcol + bj * HALF + wc * 32 + n * 16 + fr; c1v[n] = pe.c1[cg]; c2v[n] = pe.c2[cg]; }
#pragma unroll
                for (int ai = 0; ai < 2; ++ai)
#pragma unroll
                    for (int m = 0; m < 4; ++m)
#pragma unroll
                        for (int n = 0; n < 2; ++n)
#pragma unroll
                            for (int j = 0; j < 4; ++j) {
                                const int rl = ai * HALF + wr * 64 + m * 16 + fq * 4 + j;
                                const float2 ms = *reinterpret_cast<const float2*>(rst + rl * 2);
                                Qs[rl * 136 + wc * 32 + n * 16 + fr] = f2bf(ms.y * (acc[ai][bj][m][n][j] - ms.x * c1v[n]) + c2v[n]);
                            }
#pragma unroll
                for (int i = 0; i < 4; ++i) {
                    const int idx = tz + i * 512, row = idx >> 4, c8 = idx & 15;
                    *reinterpret_cast<uint4*>(Kk + row * 136 + c8 * 8) = kpre[i];
                }
                __syncthreads();
#pragma unroll
                for (int nh = 0; nh < 2; ++nh) {
                    f32x4 sacc[2][4];
#pragma unroll
                    for (int m = 0; m < 2; ++m)
#pragma unroll
                        for (int n = 0; n < 4; ++n) sacc[m][n] = f32x4{0.f, 0.f, 0.f, 0.f};
#pragma unroll
                    for (int ks = 0; ks < 4; ++ks) {
                        const bf16x8 a0 = ldfrag(Qs, 136, w8 * 32, ks * 32, lane);
                        const bf16x8 a1 = ldfrag(Qs, 136, w8 * 32 + 16, ks * 32, lane);
#pragma unroll
                        for (int n = 0; n < 4; ++n) {
                            const bf16x8 bfr = ldfrag(Kk, 136, (nh * 4 + n) * 16, ks * 32, lane);
                            sacc[0][n] = mfma16(a0, bfr, sacc[0][n]);
                            sacc[1][n] = mfma16(a1, bfr, sacc[1][n]);
                        }
                    }
                    bf16_t* stg = reinterpret_cast<bf16_t*>(rst + 512) + w8 * 32 * 72;
#pragma unroll
                    for (int m = 0; m < 2; ++m)
#pragma unroll
                        for (int n = 0; n < 4; ++n)
#pragma unroll
                            for (int jj = 0; jj < 4; ++jj)
                                stg[(m * 16 + fq * 4 + jj) * 72 + n * 16 + fr] = f2bf(sacc[m][n][jj]);
                    wave_lds_fence();
#pragma unroll
                    for (int i = 0; i < 4; ++i) {
                        const int rrow = i * 8 + (lane >> 3), c8 = (lane & 7) * 8;
                        *reinterpret_cast<uint4*>(pe.scb + (long)(brow + w8 * 32 + rrow) * N + jb * 128 + nh * 64 + c8) =
                            *reinterpret_cast<const uint4*>(stg + rrow * 72 + c8);
                    }
                    wave_lds_fence();
                }
                __syncthreads();
            }
        } else
        {
            float* Cs = reinterpret_cast<float*>(smem);
#pragma unroll
            for (int ai = 0; ai < 2; ++ai) {
                const int c4 = (tz & 63) * 4, r0 = tz >> 6;
                uint2 rpre[16];
                float4 rc = make_float4(1.f, 1.f, 1.f, 1.f), rs = make_float4(0.f, 0.f, 0.f, 0.f);
                if (EPI == EPI_RESID) {
#pragma unroll
                    for (int i = 0; i < 16; ++i) rpre[i] = *reinterpret_cast<const uint2*>(R + (long)(brow + ai * HALF + r0 + 8 * i) * N + bcol + c4);
                }
                if (EPI == EPI_PROJ && (bcol >> 8) <= 4) {
                    const int pos0 = (brow + ai * HALF + r0) & (SEQ - 1);
                    rc = *reinterpret_cast<const float4*>(pe.rope_cos + pos0 * 32 + (c4 & 31)); rs = *reinterpret_cast<const float4*>(pe.rope_sin + pos0 * 32 + (c4 & 31));
                }
#pragma unroll
                for (int bj = 0; bj < 2; ++bj)
#pragma unroll
                    for (int m = 0; m < 4; ++m)
#pragma unroll
                        for (int n = 0; n < 2; ++n)
#pragma unroll
                            for (int j = 0; j < 4; ++j)
                                Cs[(wr * 64 + m * 16 + fq * 4 + j) * 260 + bj * HALF + wc * 32 + n * 16 + fr] = acc[ai][bj][m][n][j];
                __syncthreads();
                float lb0 = 0.f, lb1 = 0.f, lb2 = 0.f, lb3 = 0.f;
                if (EPI == EPI_PROJ && ((bcol >> 8) == 7 || (bcol >> 8) == 8)) {
                    const int col = ((bcol >> 8) - 7) * 256 + c4;
                    lb0 = hgrn_lower(pe.lb, pe.l, col); lb1 = hgrn_lower(pe.lb, pe.l, col + 1);
                    lb2 = hgrn_lower(pe.lb, pe.l, col + 2); lb3 = hgrn_lower(pe.lb, pe.l, col + 3);
                }
                auto row_step = [&](int i, const uint2 rq) {
                    const int rr = r0 + 8 * i;
                    float4 v = *reinterpret_cast<const float4*>(Cs + rr * 260 + c4);
                    const long gi = (long)(brow + ai * HALF + rr) * N + bcol + c4;
                    if (EPI == EPI_PROJ) {
                        const int pn = bcol >> 8;
                        const int tok = brow + ai * HALF + rr, pos = tok & (SEQ - 1), bidx = tok >> 11;
                        if (pn <= 3 || (pn == 4 && c4 < 128)) {
                            const float4 pv = *reinterpret_cast<const float4*>(Cs + rr * 260 + (c4 ^ 32));
                            const float4 dc = *reinterpret_cast<const float4*>(pe.rope_cos + (8 * i) * 32 + (c4 & 31));
                            const float4 ds = *reinterpret_cast<const float4*>(pe.rope_sin + (8 * i) * 32 + (c4 & 31));
                            const float4 cs = make_float4(rc.x * dc.x - rs.x * ds.x, rc.y * dc.y - rs.y * ds.y, rc.z * dc.z - rs.z * ds.z, rc.w * dc.w - rs.w * ds.w);
                            const float4 sn = make_float4(rs.x * dc.x + rc.x * ds.x, rs.y * dc.y + rc.y * ds.y, rs.z * dc.z + rc.z * ds.z, rs.w * dc.w + rc.w * ds.w);
                            const float sg = (c4 & 32) ? 1.f : -1.f;
                            v.x = v.x * cs.x + sg * pv.x * sn.x; v.y = v.y * cs.y + sg * pv.y * sn.y;
                            v.z = v.z * cs.z + sg * pv.z * sn.z; v.w = v.w * cs.w + sg * pv.w * sn.w;
                            if (pn <= 3) { v.x *= 0.125f; v.y *= 0.125f; v.z *= 0.125f; v.w *= 0.125f; }
                            else if (pos >= SEQ - 128)
                                *reinterpret_cast<float4*>(pe.out + O_KP + ((((long)pe.l * 4 + bidx) * 128 + (pos - (SEQ - 128))) * 2 + (c4 >> 6)) * 64 + (c4 & 63)) = v;
                        } else if (pn == 4) {
                            if (pos >= SEQ - 128)
                                *reinterpret_cast<float4*>(pe.out + O_VP + ((((long)pe.l * 4 + bidx) * 128 + (pos - (SEQ - 128))) * 2 + ((c4 - 128) >> 6)) * 64 + (c4 & 63)) = v;
                        } else if (pn == 5 || pn == 6 || pn == 11 || pn == 12 || pn == 17 || pn == 18) {
                            v.x = siluf_(v.x); v.y = siluf_(v.y); v.z = siluf_(v.z); v.w = siluf_(v.w);
                        } else if (pn == 7 || pn == 8) {
                            v.x = __logf(fmaxf(lb0 + (1.f - lb0) * sigmoidf_(v.x), 1e-30f)); v.y = __logf(fmaxf(lb1 + (1.f - lb1) * sigmoidf_(v.y), 1e-30f));
                            v.z = __logf(fmaxf(lb2 + (1.f - lb2) * sigmoidf_(v.z), 1e-30f)); v.w = __logf(fmaxf(lb3 + (1.f - lb3) * sigmoidf_(v.w), 1e-30f));
                        } else if (pn == 13) {
                            v.x *= 0.125f; v.y *= 0.125f; v.z *= 0.125f; v.w *= 0.125f;
                        }
                        uint2 pk; pk.x = pack2(v.x, v.y); pk.y = pack2(v.z, v.w);
                        *reinterpret_cast<uint2*>(Cb + gi) = pk;
                    } else if (EPI == EPI_BF16) {
                        uint2 pk; pk.x = pack2(v.x, v.y); pk.y = pack2(v.z, v.w);
                        *reinterpret_cast<uint2*>(Cb + gi) = pk;
                    } else {
                        v.x += alpha * __uint_as_float(rq.x << 16); v.y += alpha * __uint_as_float(rq.x & 0xffff0000u);
                        v.z += alpha * __uint_as_float(rq.y << 16); v.w += alpha * __uint_as_float(rq.y & 0xffff0000u);
                        uint2 pk; pk.x = pack2(v.x, v.y); pk.y = pack2(v.z, v.w);
                        *reinterpret_cast<uint2*>(Cb + gi) = pk;
                        const float s1 = wave_sum(v.x + v.y + v.z + v.w);
                        const float s2 = wave_sum(v.x * v.x + v.y * v.y + v.z * v.z + v.w * v.w);
                        if ((tz & 63) == 0) *reinterpret_cast<float2*>(pe.zs + ((long)(brow + ai * HALF + rr) * 8 + (bcol >> 8)) * 2) = make_float2(s1, s2);
                    }
                };
                if (EPI == EPI_RESID) {
#pragma unroll
                    for (int i = 0; i < 16; ++i) row_step(i, rpre[i]);
                } else {
#pragma unroll 2
                    for (int i = 0; i < 16; ++i) row_step(i, make_uint2(0u, 0u));
                }
                __syncthreads();
            }
        }
    }
    {
        const int first_light = nwg % gridDim.x, nl = gridDim.x - first_light, nsk = N / 16;
        if ((int)blockIdx.x >= first_light)
            for (int it = blockIdx.x - first_light; it < nsk; it += nl)
                skinny_item<(EPI == EPI_PROJ ? EPI_BF16 : EPI)>(A + (long)M * K, Bt, N, K, it * 16, Cb, Cf, R, alpha, pe);
    }
#undef SA
#undef SB
#undef STAGE_X
#undef STAGE
#undef LDA
#undef LDB
#undef MMA
}

template <int EPI>
__device__ __forceinline__ void skinny_item(const bf16_t* __restrict__ A  , const bf16_t* __restrict__ Bt, int N, int K, int n0,
                                            bf16_t* __restrict__ Cb, float* __restrict__ Cf, const bf16_t* __restrict__ R, float alpha, const ProjEpi pe) {
    extern __shared__ __attribute__((aligned(16))) char smem[];
    float* red = reinterpret_cast<float*>(smem);
    const int tid = otid(), lane = tid & 63, w = tid >> 6, r = lane & 15, q4 = lane >> 4;
    const int kw = K / 8;
    f32x4 acc[2] = {f32x4{0.f, 0.f, 0.f, 0.f}, f32x4{0.f, 0.f, 0.f, 0.f}};
    const bf16_t* a0 = A + (long)r * K + w * kw + q4 * 8;
    const bf16_t* a1 = A + (long)(16 + r) * K + w * kw + q4 * 8;
    const bf16_t* bp = Bt + (long)(n0 + r) * K + w * kw + q4 * 8;
    {
        bf16x8 fa0[8], fa1[8], fb[8];
#pragma unroll
        for (int ks = 0; ks < 8; ++ks) {
            fa0[ks] = *reinterpret_cast<const bf16x8*>(a0 + ks * 32);
            fa1[ks] = *reinterpret_cast<const bf16x8*>(a1 + ks * 32);
            fb[ks] = *reinterpret_cast<const bf16x8*>(bp + ks * 32);
        }
#pragma unroll
        for (int ks = 0; ks < 8; ++ks) {
            acc[0] = mfma16(fa0[ks], fb[ks], acc[0]);
            acc[1] = mfma16(fa1[ks], fb[ks], acc[1]);
        }
    }
    *reinterpret_cast<f32x4*>(red + ((w * 2 + 0) * 64 + lane) * 4) = acc[0];
    *reinterpret_cast<f32x4*>(red + ((w * 2 + 1) * 64 + lane) * 4) = acc[1];
    float* srst = red + 8 * 2 * 64 * 4;
    if (EPI == EPI_SCORES) {
        const int row = tid >> 4, part = tid & 15;
        const bf16_t* zr = pe.zb + (long)(TPROMPT + row) * K + part * 128;
        float s1 = 0.f, s2 = 0.f;
#pragma unroll
        for (int i = 0; i < 16; ++i) {
            float f[8]; unpack8(*reinterpret_cast<const uint4*>(zr + i * 8), f);
#pragma unroll
            for (int j = 0; j < 8; ++j) { s1 += f[j]; s2 += f[j] * f[j]; }
        }
        s1 = row16_sum(s1); s2 = row16_sum(s2);
        if (part == 0) { const float mean = s1 * (1.f / DM); srst[row * 2] = mean; srst[row * 2 + 1] = rsqrtf(fmaxf(s2 * (1.f / DM) - mean * mean, 0.f) + 1e-5f); }
    }
    __syncthreads();
    if (tid < 128) {
        const int mt = tid >> 6;
        f32x4 s = f32x4{0.f, 0.f, 0.f, 0.f};
#pragma unroll
        for (int ww_ = 0; ww_ < 8; ++ww_) s += *reinterpret_cast<const f32x4*>(red + ((ww_ * 2 + mt) * 64 + lane) * 4);
        float rres[4] = {0.f, 0.f, 0.f, 0.f};
        if (EPI == EPI_RESID) {
#pragma unroll
            for (int jj = 0; jj < 4; ++jj) rres[jj] = bf2f(R[(long)(TPROMPT + mt * 16 + q4 * 4 + jj) * N + n0 + r]);
        }
#pragma unroll
        for (int jj = 0; jj < 4; ++jj) {
            const int row = TPROMPT + mt * 16 + q4 * 4 + jj;
            const long gi = (long)row * N + n0 + r;
            if (EPI == EPI_BF16) Cb[gi] = f2bf(s[jj]);
            else if (EPI == EPI_SCORES) {
                const float mean = srst[(mt * 16 + q4 * 4 + jj) * 2], rstd = srst[(mt * 16 + q4 * 4 + jj) * 2 + 1];
                Cb[gi] = f2bf(rstd * (s[jj] - mean * pe.c1[n0 + r]) + pe.c2[n0 + r]);
            } else {
                const float z = s[jj] + alpha * rres[jj];
                Cb[gi] = f2bf(z);
            }
        }
    }
    __syncthreads();
}

__device__ __forceinline__ unsigned pair_lo(unsigned a, unsigned b) { return (a & 0xffffu) | (b << 16); }
__device__ __forceinline__ unsigned pair_hi(unsigned a, unsigned b) { return (a >> 16) | (b & 0xffff0000u); }
__device__ __forceinline__ void store_pairs_T(unsigned* dst, int stride_dw, const uint4 a, const uint4 b) {
    dst[0 * stride_dw] = pair_lo(a.x, b.x); dst[1 * stride_dw] = pair_hi(a.x, b.x);
    dst[2 * stride_dw] = pair_lo(a.y, b.y); dst[3 * stride_dw] = pair_hi(a.y, b.y);
    dst[4 * stride_dw] = pair_lo(a.z, b.z); dst[5 * stride_dw] = pair_hi(a.z, b.z);
    dst[6 * stride_dw] = pair_lo(a.w, b.w); dst[7 * stride_dw] = pair_hi(a.w, b.w);
}
__device__ __forceinline__ void attn_prompt_item(const Params& p, int l, int item) {
    extern __shared__ __attribute__((aligned(16))) char smem[];
    bf16_t* Ks = reinterpret_cast<bf16_t*>(smem);
    bf16_t* Vt = Ks + 256 * 72;
    bf16_t* Ps = Vt + 64 * 264;
    const int tid = otid(), lane = tid & 63, w = __builtin_amdgcn_readfirstlane(tid >> 6);
    const int hq2 = item & 1, g = (item >> 1) & 1, blk = (item >> 2) & 15, b = item >> 6;
    const long tokw = (long)b * SEQ + (blk - 1) * 128;
    const uint4 z4 = make_uint4(0u, 0u, 0u, 0u);
    {
        const int c8 = tid & 7, j0 = tid >> 3;
        const bool lo_ok = blk > 0;
        const bf16_t* kp = p.PROJ + C_KA + g * 64 + c8 * 8;
        const uint4 k0 = *reinterpret_cast<const uint4*>(kp + (tokw + (lo_ok ? j0 : 128)) * NINP);
        const uint4 k1 = *reinterpret_cast<const uint4*>(kp + (tokw + (lo_ok ? j0 + 64 : 128)) * NINP);
        const uint4 k2 = *reinterpret_cast<const uint4*>(kp + (tokw + j0 + 128) * NINP);
        const uint4 k3 = *reinterpret_cast<const uint4*>(kp + (tokw + j0 + 192) * NINP);
        const int jp = tid & 127, eg = tid >> 7;
        const bool vok = (blk > 0) || (jp >= 64);
        const bf16_t* v0 = p.PROJ + (tokw + 2 * (vok ? jp : 64)) * NINP + C_VA + g * 64 + eg * 16;
        uint4 a0 = *reinterpret_cast<const uint4*>(v0), a1 = *reinterpret_cast<const uint4*>(v0 + 8);
        uint4 b0 = *reinterpret_cast<const uint4*>(v0 + NINP), b1 = *reinterpret_cast<const uint4*>(v0 + NINP + 8);
        __builtin_amdgcn_sched_barrier(0);
        const unsigned km = lo_ok ? 0xffffffffu : 0u;
        *reinterpret_cast<uint4*>(Ks + j0 * 72 + c8 * 8) = make_uint4(k0.x & km, k0.y & km, k0.z & km, k0.w & km);
        *reinterpret_cast<uint4*>(Ks + (j0 + 64) * 72 + c8 * 8) = make_uint4(k1.x & km, k1.y & km, k1.z & km, k1.w & km);
        *reinterpret_cast<uint4*>(Ks + (j0 + 128) * 72 + c8 * 8) = k2;
        *reinterpret_cast<uint4*>(Ks + (j0 + 192) * 72 + c8 * 8) = k3;
        const unsigned vm = vok ? 0xffffffffu : 0u;
        a0 = make_uint4(a0.x & vm, a0.y & vm, a0.z & vm, a0.w & vm); a1 = make_uint4(a1.x & vm, a1.y & vm, a1.z & vm, a1.w & vm);
        b0 = make_uint4(b0.x & vm, b0.y & vm, b0.z & vm, b0.w & vm); b1 = make_uint4(b1.x & vm, b1.y & vm, b1.z & vm, b1.w & vm);
        unsigned* vd = reinterpret_cast<unsigned*>(Vt) + (eg * 16) * 132 + jp;
        store_pairs_T(vd, 132, a0, b0);
        store_pairs_T(vd + 8 * 132, 132, a1, b1);
    }
    __syncthreads();
    const int r = lane & 15, q4 = lane >> 4;
    const int i0 = w * 16;
    const int lo = (blk == 0 && w < 8) ? 8 : w, hi = w + 8;
    const int tlo = lo & ~1, thi = hi | 1;
    bf16_t* Pw = Ps + w * 16 * 264;
    const bf16_t* qbase = p.PROJ + ((long)b * SEQ + blk * 128 + i0 + r) * NINP + C_QA + (g * 8 + hq2 * 4) * 64 + q4 * 8;
    bf16x8 qn[2];
    qn[0] = *reinterpret_cast<const bf16x8*>(qbase);
    qn[1] = *reinterpret_cast<const bf16x8*>(qbase + 32);
    if (blk > 0) {
        const int tb = w & ~1;
        const int zt = (w & 1) ? (w - 1) : (w + 9);
        for (int hh = 0; hh < 4; ++hh) {
            const int qh = g * 8 + hq2 * 4 + hh;
            bf16x8 qa[2];
            qa[0] = qn[0]; qa[1] = qn[1];
            if (hh < 3) {
                qn[0] = *reinterpret_cast<const bf16x8*>(qbase + (hh + 1) * 64);
                qn[1] = *reinterpret_cast<const bf16x8*>(qbase + (hh + 1) * 64 + 32);
            }
            f32x4 acc[9];
#pragma unroll
            for (int rt = 0; rt < 9; ++rt) {
                acc[rt] = f32x4{0.f, 0.f, 0.f, 0.f};
#pragma unroll
                for (int ks = 0; ks < 2; ++ks) acc[rt] = mfma16(qa[ks], ldfrag(Ks, 72, (w + rt) * 16, ks * 32, lane), acc[rt]);
            }
            const float sink = p.sinks[l * 16 + qh];
#pragma unroll
            for (int jj = 0; jj < 4; ++jj) {
                const int qi = q4 * 4 + jj;
                const float s0 = (r >= qi) ? acc[0][jj] : -1e30f, s8 = (r <= qi) ? acc[8][jj] : -1e30f;
                float m = fmaxf(s0, s8);
#pragma unroll
                for (int rt = 1; rt < 8; ++rt) m = fmaxf(m, acc[rt][jj]);
                m = row16_max(m); m = fmaxf(m, sink);
                float pv[9];
                pv[0] = __expf(s0 - m); pv[8] = __expf(s8 - m);
                float sum = pv[0] + pv[8];
#pragma unroll
                for (int rt = 1; rt < 8; ++rt) { pv[rt] = __expf(acc[rt][jj] - m); sum += pv[rt]; }
                sum = row16_sum(sum);
                const float inv = __builtin_amdgcn_rcpf(sum + __expf(sink - m));
                bf16_t* prow = Pw + qi * 264 + w * 16 + r;
#pragma unroll
                for (int rt = 0; rt < 9; ++rt) prow[rt * 16] = f2bf(pv[rt] * inv);
                Pw[qi * 264 + zt * 16 + r] = 0;
            }
            wave_lds_fence();
            f32x4 o[4];
#pragma unroll
            for (int nt = 0; nt < 4; ++nt) o[nt] = f32x4{0.f, 0.f, 0.f, 0.f};
#pragma unroll
            for (int c = 0; c < 5; ++c) {
                const int k0 = (tb * 16) + c * 32;
                const bf16x8 pa = ldfrag(Pw, 264, 0, k0, lane);
#pragma unroll
                for (int nt = 0; nt < 4; ++nt) o[nt] = mfma16(pa, ldfrag(Vt, 264, nt * 16, k0, lane), o[nt]);
            }
#pragma unroll
            for (int nt = 0; nt < 4; ++nt)
#pragma unroll
                for (int jj = 0; jj < 4; ++jj) {
                    const long tok = (long)b * SEQ + blk * 128 + i0 + q4 * 4 + jj;
                    p.OCAT[tok * DM + qh * 64 + nt * 16 + r] = f2bf(o[nt][jj]);
                }
            wave_lds_fence();
        }
    } else {
    for (int hh = 0; hh < 4; ++hh) {
        const int qh = g * 8 + hq2 * 4 + hh;
        bf16x8 qa[2];
        qa[0] = qn[0]; qa[1] = qn[1];
        if (hh < 3) {
            qn[0] = *reinterpret_cast<const bf16x8*>(qbase + (hh + 1) * 64);
            qn[1] = *reinterpret_cast<const bf16x8*>(qbase + (hh + 1) * 64 + 32);
        }
        f32x4 acc[16];
#pragma unroll
        for (int nt = 0; nt < 16; ++nt) {
            acc[nt] = f32x4{0.f, 0.f, 0.f, 0.f};
            if (nt >= lo && nt <= hi) {
#pragma unroll
                for (int ks = 0; ks < 2; ++ks) acc[nt] = mfma16(qa[ks], ldfrag(Ks, 72, nt * 16, ks * 32, lane), acc[nt]);
            }
        }
        const float sink = p.sinks[l * 16 + qh];
#pragma unroll
        for (int jj = 0; jj < 4; ++jj) {
            const int i = i0 + q4 * 4 + jj;
            float m = -1e30f;
#pragma unroll
            for (int nt = 0; nt < 16; ++nt) {
                if (nt >= tlo && nt <= thi) {
                    const int j = nt * 16 + r, diff = i + 128 - j;
                    const bool valid = (diff >= 0) && (diff <= 128) && (blk > 0 || j >= 128);
                    const float s = valid ? acc[nt][jj] : -1e30f;
                    acc[nt][jj] = s; m = fmaxf(m, s);
                }
            }
            m = row16_max(m); m = fmaxf(m, sink);
            float sum = 0.f;
#pragma unroll
            for (int nt = 0; nt < 16; ++nt) {
                if (nt >= tlo && nt <= thi) {
                    const float s = acc[nt][jj];
                    const float pv = (s > -1e29f) ? __expf(s - m) : 0.f;
                    acc[nt][jj] = pv; sum += pv;
                }
            }
            sum = row16_sum(sum);
            const float inv = 1.f / (sum + __expf(sink - m));
#pragma unroll
            for (int nt = 0; nt < 16; ++nt)
                if (nt >= tlo && nt <= thi) Pw[(q4 * 4 + jj) * 264 + nt * 16 + r] = f2bf(acc[nt][jj] * inv);
        }
        wave_lds_fence();
        f32x4 o[4];
#pragma unroll
        for (int nt = 0; nt < 4; ++nt) o[nt] = f32x4{0.f, 0.f, 0.f, 0.f};
#pragma unroll
        for (int ks = 0; ks < 8; ++ks) {
            if (ks >= (tlo >> 1) && ks <= (thi >> 1)) {
                const bf16x8 pa = ldfrag(Pw, 264, 0, ks * 32, lane);
#pragma unroll
                for (int nt = 0; nt < 4; ++nt) o[nt] = mfma16(pa, ldfrag(Vt, 264, nt * 16, ks * 32, lane), o[nt]);
            }
        }
#pragma unroll
        for (int nt = 0; nt < 4; ++nt)
#pragma unroll
            for (int jj = 0; jj < 4; ++jj) {
                const long tok = (long)b * SEQ + blk * 128 + i0 + q4 * 4 + jj;
                p.OCAT[tok * DM + qh * 64 + nt * 16 + r] = f2bf(o[nt][jj]);
            }
        wave_lds_fence();
    }
    }
    __syncthreads();
}

__device__ __forceinline__ void attn_sample_wave(const Params& p, int l, int item, float* wl) {
    const int lane = otid() & 63;
    const int b = item >> 4, qh = item & 15, g = qh >> 3;
    const long tok = TPROMPT + b;
    const bf16_t* pr = p.PROJ + tok * NINP;
    const float* cs = p.rope_cos + 2048 * 32;
    const float* sn = p.rope_sin + 2048 * 32;
    float* qs = wl; float* kn = wl + 64; float* vn = wl + 128;
    {
        const int d = lane, dp = d & 31;
        const float c = cs[dp], s = sn[dp];
        const float x1 = bf2f(pr[C_QA + qh * 64 + dp]), x2 = bf2f(pr[C_QA + qh * 64 + 32 + dp]);
        qs[d] = ((d < 32) ? (x1 * c - x2 * s) : (x2 * c + x1 * s)) * 0.125f;
        const float k1 = bf2f(pr[C_KA + g * 64 + dp]), k2 = bf2f(pr[C_KA + g * 64 + 32 + dp]);
        kn[d] = (d < 32) ? (k1 * c - k2 * s) : (k2 * c + k1 * s);
        vn[d] = bf2f(pr[C_VA + g * 64 + d]);
    }
    wave_lds_fence();
    const float* ck = p.cache_k + ((long)(l * 32 + b) * 128) * 128 + g * 64;
    const float* cv = p.cache_v + ((long)(l * 32 + b) * 128) * 128 + g * 64;
    float* ok = p.out + O_KS + ((long)(l * 32 + b) * 128) * 128 + g * 64;
    float* ov = p.out + O_VS + ((long)(l * 32 + b) * 128) * 128 + g * 64;
    const int jr = lane >> 4, c4 = (lane & 15) * 4;
    const int sel = qh & 7;
    const float4 q4v = *reinterpret_cast<const float4*>(qs + c4);
    const float4 kn4 = *reinterpret_cast<const float4*>(kn + c4);
    const float4 vn4 = *reinterpret_cast<const float4*>(vn + c4);
    float4 kv[32];
#pragma unroll
    for (int i = 0; i < 32; ++i) kv[i] = *reinterpret_cast<const float4*>(ck + (long)(4 * i + jr) * 128 + c4);
    float sc[32];
    float m = -3.0e38f;
#pragma unroll
    for (int i = 0; i < 32; ++i) {
        sc[i] = row16_sum(q4v.x * kv[i].x + q4v.y * kv[i].y + q4v.z * kv[i].z + q4v.w * kv[i].w);
        m = fmaxf(m, sc[i]);
        if ((i >> 2) == sel) { const int j = 4 * i + jr; if (j >= 1) *reinterpret_cast<float4*>(ok + (long)(j - 1) * 128 + c4) = kv[i]; }
    }
    const float s2 = row16_sum(q4v.x * kn4.x + q4v.y * kn4.y + q4v.z * kn4.z + q4v.w * kn4.w);
    const float sink = p.sinks[l * 16 + qh];
    m = fmaxf(fmaxf(rdlane(m, 0), rdlane(m, 16)), fmaxf(rdlane(m, 32), rdlane(m, 48)));
    m = fmaxf(m, fmaxf(s2, sink));
    float4 vv[32];
#pragma unroll
    for (int i = 0; i < 32; ++i) vv[i] = *reinterpret_cast<const float4*>(cv + (long)(4 * i + jr) * 128 + c4);
    float lsum = 0.f;
#pragma unroll
    for (int i = 0; i < 32; ++i) { sc[i] = __expf(sc[i] - m); lsum += sc[i]; }
    const float p2 = __expf(s2 - m);
    const float den = (rdlane(lsum, 0) + rdlane(lsum, 16)) + (rdlane(lsum, 32) + rdlane(lsum, 48)) + p2 + __expf(sink - m);
    const float inv = 1.f / den;
    float4 o4 = make_float4(0.f, 0.f, 0.f, 0.f);
#pragma unroll
    for (int i = 0; i < 32; ++i) {
        o4.x += sc[i] * vv[i].x; o4.y += sc[i] * vv[i].y; o4.z += sc[i] * vv[i].z; o4.w += sc[i] * vv[i].w;
        if ((i >> 2) == sel) { const int j = 4 * i + jr; if (j >= 1) *reinterpret_cast<float4*>(ov + (long)(j - 1) * 128 + c4) = vv[i]; }
    }
    o4.x += __shfl_xor(o4.x, 16); o4.y += __shfl_xor(o4.y, 16); o4.z += __shfl_xor(o4.z, 16); o4.w += __shfl_xor(o4.w, 16);
    o4.x += __shfl_xor(o4.x, 32); o4.y += __shfl_xor(o4.y, 32); o4.z += __shfl_xor(o4.z, 32); o4.w += __shfl_xor(o4.w, 32);
    if (jr == 0) {
        uint2 pk;
        pk.x = pack2((o4.x + p2 * vn4.x) * inv, (o4.y + p2 * vn4.y) * inv);
        pk.y = pack2((o4.z + p2 * vn4.z) * inv, (o4.w + p2 * vn4.w) * inv);
        *reinterpret_cast<uint2*>(p.OCAT + tok * DM + qh * 64 + c4) = pk;
        if (sel == 7) {
            *reinterpret_cast<float4*>(ok + 127L * 128 + c4) = kn4;
            *reinterpret_cast<float4*>(ov + 127L * 128 + c4) = vn4;
        }
    }
    wave_lds_fence();
}

template <int KIND>
__device__ __forceinline__ float log_decay_raw(const Params& p, int l, const bf16_t* pr, int h, int d, float& kval) {
    if (KIND == 0) {
        const int col = h * 128 + d;
        const float z = bf2f(pr[C_FB + col]);
        const float lb = hgrn_lower(p.lb_logits, l, col);
        const float f = lb + (1.f - lb) * sigmoidf_(z);
        kval = 1.f - f;
        return __logf(fmaxf(f, 1e-30f));
    } else {
        const int col = h * 64 + d;
        float ac[16], wa[16];
        unpack8(*reinterpret_cast<const uint4*>(pr + C_AC), ac); unpack8(*reinterpret_cast<const uint4*>(pr + C_AC + 8), ac + 8);
#pragma unroll
        for (int r = 0; r < 16; ++r) wa[r] = p.gla_wa2[(l * 16 + r) * 256 + col];
        float a = p.gla_ba[l * 256 + col];
#pragma unroll
        for (int r = 0; r < 16; ++r) a += ac[r] * wa[r];
        kval = bf2f(pr[C_KC + col]);
        return logsigmoidf_(a) * (1.f / 16.f);
    }
}
template <int CTRL> __device__ __forceinline__ float dpp_zero(float v) {
    return __int_as_float(__builtin_amdgcn_update_dpp(0, __float_as_int(v), CTRL, 0xf, 0xf, true));
}
__device__ __forceinline__ float scan32(float x) {
    x += dpp_zero<0x111>(x); x += dpp_zero<0x112>(x); x += dpp_zero<0x114>(x); x += dpp_zero<0x118>(x);
    x += __int_as_float(__builtin_amdgcn_update_dpp(0, __float_as_int(x), 0x142, 0xA, 0xf, false));
    return x;
}
template <int KIND>
struct ChunkDecay { float b0[8], b1[8], k0[8], k1[8]; };
template <int KIND, bool STORE_LFC>
__device__ __forceinline__ void chunk_decay(const Params& p, int l, long tokp, int h, int dg, ChunkDecay<KIND>& cd) {
    const bf16_t* pr0 = p.PROJ + tokp * NINP;
    const bf16_t* pr1 = pr0 + NINP;
    float lf0[8], lf1[8];
    if (KIND == 0) {
        unpack8(*reinterpret_cast<const uint4*>(pr0 + C_FB + h * 128 + dg * 8), lf0);
        unpack8(*reinterpret_cast<const uint4*>(pr1 + C_FB + h * 128 + dg * 8), lf1);
#pragma unroll
        for (int i = 0; i < 8; ++i) { cd.k0[i] = 1.f - __expf(lf0[i]); cd.k1[i] = 1.f - __expf(lf1[i]); }
    } else {
        unpack8(*reinterpret_cast<const uint4*>(pr0 + C_KC + h * 64 + dg * 8), cd.k0);
        unpack8(*reinterpret_cast<const uint4*>(pr1 + C_KC + h * 64 + dg * 8), cd.k1);
        if (STORE_LFC) {
            float a0[16], a1[16];
            unpack8(*reinterpret_cast<const uint4*>(pr0 + C_AC), a0); unpack8(*reinterpret_cast<const uint4*>(pr0 + C_AC + 8), a0 + 8);
            unpack8(*reinterpret_cast<const uint4*>(pr1 + C_AC), a1); unpack8(*reinterpret_cast<const uint4*>(pr1 + C_AC + 8), a1 + 8);
            const float* wa = p.gla_wa2 + (long)l * 16 * 256 + h * 64 + dg * 8;
            const float* ba = p.gla_ba + l * 256 + h * 64 + dg * 8;
            float g0[8], g1[8];
#pragma unroll
            for (int i = 0; i < 8; ++i) { g0[i] = ba[i]; g1[i] = ba[i]; }
#pragma unroll
            for (int r = 0; r < 16; ++r) {
                const float4 w0 = *reinterpret_cast<const float4*>(wa + r * 256), w1 = *reinterpret_cast<const float4*>(wa + r * 256 + 4);
                const float wv[8] = {w0.x, w0.y, w0.z, w0.w, w1.x, w1.y, w1.z, w1.w};
#pragma unroll
                for (int i = 0; i < 8; ++i) { g0[i] += a0[r] * wv[i]; g1[i] += a1[r] * wv[i]; }
            }
#pragma unroll
            for (int i = 0; i < 8; ++i) { g0[i] = logsigmoidf_(g0[i]) * (1.f / 16.f); g1[i] = logsigmoidf_(g1[i]) * (1.f / 16.f); }
            const uint4 u0 = pack8(g0), u1 = pack8(g1);
            *reinterpret_cast<uint4*>(p.LFC + tokp * 256 + h * 64 + dg * 8) = u0;
            *reinterpret_cast<uint4*>(p.LFC + (tokp + 1) * 256 + h * 64 + dg * 8) = u1;
            unpack8(u0, lf0); unpack8(u1, lf1);
        } else {
            unpack8(*reinterpret_cast<const uint4*>(p.LFC + tokp * 256 + h * 64 + dg * 8), lf0);
            unpack8(*reinterpret_cast<const uint4*>(p.LFC + (tokp + 1) * 256 + h * 64 + dg * 8), lf1);
        }
    }
#pragma unroll
    for (int i = 0; i < 8; ++i) {
        const float p1 = lf0[i] + lf1[i];
        const float S = scan32(p1);
        cd.b0[i] = S - lf1[i];
        cd.b1[i] = S;
    }
}

template <int KIND>
__device__ __forceinline__ void rec_local_item(const Params& p, int l, int item) {
    constexpr int DK = KIND == 0 ? 128 : 64, NDT = DK / 16;
    constexpr int VOFF = KIND == 0 ? C_IB : C_VC;
    extern __shared__ __attribute__((aligned(16))) char smem[];
    bf16_t* kdT = reinterpret_cast<bf16_t*>(smem);
    bf16_t* vT = kdT + DK * 72;
    const int tid = otid(), lane = tid & 63, w = __builtin_amdgcn_readfirstlane(tid >> 6), sp = tid & 31, dg = tid >> 5;
    const int c = item & 31, h = (item >> 5) & 3, b = item >> 7, bh = b * 4 + h;
    const long tok0 = (long)b * SEQ + c * 64;
    const long tokp = tok0 + 2 * sp;
    {
        const bf16_t* v0 = p.PROJ + tokp * NINP + VOFF + h * 128 + dg * 8;
        store_pairs_T(reinterpret_cast<unsigned*>(vT) + (dg * 8) * 36 + sp, 36,
                      *reinterpret_cast<const uint4*>(v0), *reinterpret_cast<const uint4*>(v0 + NINP));
    }
    if (w < DK / 16) {
        ChunkDecay<KIND> cd;
        chunk_decay<KIND, true>(p, l, tokp, h, dg, cd);
        float* Dg = (KIND == 0 ? p.HD : p.GD) + (long)(bh * 32 + c) * DK + dg * 8;
        unsigned* kd = reinterpret_cast<unsigned*>(kdT) + (dg * 8) * 36 + sp;
#pragma unroll
        for (int i = 0; i < 8; ++i) {
            const float be = (lane < 32) ? rdlane(cd.b1[i], 31) : rdlane(cd.b1[i], 63);
            kd[i * 36] = pack2(cd.k0[i] * __expf(be - cd.b0[i]), cd.k1[i] * __expf(be - cd.b1[i]));
            if (sp == 0) Dg[i] = __expf(be);
        }
    }
    __syncthreads();
    f32x4 acc[NDT];
#pragma unroll
    for (int n = 0; n < NDT; ++n) acc[n] = f32x4{0.f, 0.f, 0.f, 0.f};
#pragma unroll
    for (int ks = 0; ks < 2; ++ks) {
        const bf16x8 a = ldfrag(vT, 72, w * 16, ks * 32, lane);
#pragma unroll
        for (int n = 0; n < NDT; ++n) acc[n] = mfma16(a, ldfrag(kdT, 72, n * 16, ks * 32, lane), acc[n]);
    }
    bf16_t* ST = (KIND == 0 ? p.HST : p.GST) + ((long)bh * 33 + c + 1) * DK * 128;
    bf16_t* stg = vT + 128 * 72;
    const int r = lane & 15, q4 = lane >> 4;
#pragma unroll
    for (int n = 0; n < NDT; ++n)
#pragma unroll
        for (int jj = 0; jj < 4; ++jj) stg[(w * 16 + q4 * 4 + jj) * (DK + 8) + n * 16 + r] = f2bf(acc[n][jj]);
    __syncthreads();
#pragma unroll
    for (int i = 0; i < DK / 32; ++i) {
        const int idx = tid + i * 512, e = idx / (DK / 8), c8 = (idx % (DK / 8)) * 8;
        *reinterpret_cast<uint4*>(ST + e * DK + c8) = *reinterpret_cast<const uint4*>(stg + e * (DK + 8) + c8);
    }
    __syncthreads();
}

template <int KIND>
__device__ __forceinline__ void rec_out_item(const Params& p, int l, int item) {
    constexpr int DK = KIND == 0 ? 128 : 64, QS = DK + 8, NKS = DK / 32, EPT = DK / 4;
    constexpr int VOFF = KIND == 0 ? C_IB : C_VC, GOFF = KIND == 0 ? C_GB : C_GC, QOFF = KIND == 0 ? C_QB : C_QC;
    extern __shared__ __attribute__((aligned(16))) char smem[];
    float* Os = reinterpret_cast<float*>(smem);
    bf16_t* qr = reinterpret_cast<bf16_t*>(smem + 33792);
    bf16_t* kr = qr + 64 * QS;
    bf16_t* STt = kr + 64 * QS;
    bf16_t* vT = STt + 128 * QS;
    bf16_t* aP = vT + 128 * 72;
    float* erv = reinterpret_cast<float*>(aP + 64 * 72);
    const int tid = otid(), lane = tid & 63, w = __builtin_amdgcn_readfirstlane(tid >> 6), sp = tid & 31, dg = tid >> 5;
    const int c = item & 31, h = (item >> 5) & 3, b = item >> 7, bh = b * 4 + h;
    const long tok0 = (long)b * SEQ + c * 64;
    const long tokp = tok0 + 2 * sp;
    const float* nw = (KIND == 0 ? p.hgrn_nw : p.gla_nw) + (l * 4 + h) * 128;
    const float nw0 = nw[lane], nw1 = nw[lane + 64];
    bf16_t gq0[8], gq1[8];
#pragma unroll
    for (int i = 0; i < 8; ++i) {
        const bf16_t* pr = p.PROJ + (tok0 + w * 8 + i) * NINP + GOFF + h * 128;
        gq0[i] = pr[lane]; gq1[i] = pr[lane + 64];
    }
    uint4 stv[EPT / 8];
    {
        const bf16_t* ST = (KIND == 0 ? p.HST : p.GST) + ((long)bh * 33 + c) * DK * 128;
        const int e = tid >> 2, d0 = (tid & 3) * EPT;
#pragma unroll
        for (int u = 0; u < EPT / 8; ++u) stv[u] = *reinterpret_cast<const uint4*>(ST + e * DK + d0 + u * 8);
    }
    {
        const bf16_t* v0 = p.PROJ + tokp * NINP + VOFF + h * 128 + dg * 8;
        store_pairs_T(reinterpret_cast<unsigned*>(vT) + (dg * 8) * 36 + sp, 36,
                      *reinterpret_cast<const uint4*>(v0), *reinterpret_cast<const uint4*>(v0 + NINP));
    }
    if (w < DK / 16) {
        ChunkDecay<KIND> cd;
        chunk_decay<KIND, false>(p, l, tokp, h, dg, cd);
        float q0[8], q1[8];
        unpack8(*reinterpret_cast<const uint4*>(p.PROJ + tokp * NINP + QOFF + h * DK + dg * 8), q0);
        unpack8(*reinterpret_cast<const uint4*>(p.PROJ + (tokp + 1) * NINP + QOFF + h * DK + dg * 8), q1);
        float a0[8], a1[8], c0[8], c1[8];
#pragma unroll
        for (int i = 0; i < 8; ++i) {
            const float rr = (lane < 32) ? rdlane(cd.b1[i], 15) : rdlane(cd.b1[i], 47);
            a0[i] = q0[i] * __expf(fminf(cd.b0[i] - rr, 80.f)); a1[i] = q1[i] * __expf(fminf(cd.b1[i] - rr, 80.f));
            c0[i] = cd.k0[i] * __expf(fminf(rr - cd.b0[i], 80.f)); c1[i] = cd.k1[i] * __expf(fminf(rr - cd.b1[i], 80.f));
            if (sp == 0) erv[dg * 8 + i] = __expf(rr);
        }
        *reinterpret_cast<uint4*>(qr + (2 * sp) * QS + dg * 8) = pack8(a0);
        *reinterpret_cast<uint4*>(qr + (2 * sp + 1) * QS + dg * 8) = pack8(a1);
        *reinterpret_cast<uint4*>(kr + (2 * sp) * QS + dg * 8) = pack8(c0);
        *reinterpret_cast<uint4*>(kr + (2 * sp + 1) * QS + dg * 8) = pack8(c1);
    }
    __syncthreads();
    {
        const int e = tid >> 2, d0 = (tid & 3) * EPT;
#pragma unroll
        for (int u = 0; u < EPT / 8; ++u) {
            float sf[8]; unpack8(stv[u], sf);
            const float4 r0 = *reinterpret_cast<const float4*>(erv + d0 + u * 8);
            const float4 r1 = *reinterpret_cast<const float4*>(erv + d0 + u * 8 + 4);
            const float f[8] = {sf[0] * r0.x, sf[1] * r0.y, sf[2] * r0.z, sf[3] * r0.w, sf[4] * r1.x, sf[5] * r1.y, sf[6] * r1.z, sf[7] * r1.w};
            *reinterpret_cast<uint4*>(STt + e * QS + d0 + u * 8) = pack8(f);
        }
    }
    const int r = lane & 15, q4 = lane >> 4;
    {
        const int rt = w >> 1, ct0 = (w & 1) * 2;
        f32x4 a2[2] = {f32x4{0.f, 0.f, 0.f, 0.f}, f32x4{0.f, 0.f, 0.f, 0.f}};
#pragma unroll
        for (int ks = 0; ks < NKS; ++ks) {
            const bf16x8 a = ldfrag(qr, QS, rt * 16, ks * 32, lane);
#pragma unroll
            for (int n = 0; n < 2; ++n) a2[n] = mfma16(a, ldfrag(kr, QS, (ct0 + n) * 16, ks * 32, lane), a2[n]);
        }
#pragma unroll
        for (int n = 0; n < 2; ++n)
#pragma unroll
            for (int jj = 0; jj < 4; ++jj) {
                const int t = rt * 16 + q4 * 4 + jj, s = (ct0 + n) * 16 + r;
                aP[t * 72 + s] = f2bf((s <= t) ? a2[n][jj] : 0.f);
            }
    }
    __syncthreads();
    {
        const int rt = w & 3, nt0 = (w >> 2) * 4;
        f32x4 acc[4];
#pragma unroll
        for (int n = 0; n < 4; ++n) acc[n] = f32x4{0.f, 0.f, 0.f, 0.f};
#pragma unroll
        for (int ks = 0; ks < NKS; ++ks) {
            const bf16x8 a = ldfrag(qr, QS, rt * 16, ks * 32, lane);
#pragma unroll
            for (int n = 0; n < 4; ++n) acc[n] = mfma16(a, ldfrag(STt, QS, (nt0 + n) * 16, ks * 32, lane), acc[n]);
        }
#pragma unroll
        for (int ks = 0; ks < 2; ++ks) {
            const bf16x8 a = ldfrag(aP, 72, rt * 16, ks * 32, lane);
#pragma unroll
            for (int n = 0; n < 4; ++n) acc[n] = mfma16(a, ldfrag(vT, 72, (nt0 + n) * 16, ks * 32, lane), acc[n]);
        }
#pragma unroll
        for (int n = 0; n < 4; ++n)
#pragma unroll
            for (int jj = 0; jj < 4; ++jj) Os[(rt * 16 + q4 * 4 + jj) * 132 + (nt0 + n) * 16 + r] = acc[n][jj];
    }
    __syncthreads();
    {
#pragma unroll
        for (int i = 0; i < 8; ++i) {
            const int t = w * 8 + i;
            const float x0 = Os[t * 132 + lane], x1 = Os[t * 132 + 64 + lane];
            const float ss = wave_sum(x0 * x0 + x1 * x1);
            const float inv = rsqrtf(ss * (1.f / 128.f) + 1e-6f);
            bf16_t* oc = p.OCAT + (tok0 + t) * DM + 1024 + KIND * 512 + h * 128;
            oc[lane] = f2bf(x0 * inv * nw0 * bf2f(gq0[i]));
            oc[lane + 64] = f2bf(x1 * inv * nw1 * bf2f(gq1[i]));
        }
    }
    __syncthreads();
}

template <int KIND>
__device__ __forceinline__ void rec_sample_item(const Params& p, int l, int item) {
    constexpr int DK = KIND == 0 ? 128 : 64;
    constexpr int VOFF = KIND == 0 ? C_IB : C_VC, GOFF = KIND == 0 ? C_GB : C_GC;
    extern __shared__ __attribute__((aligned(16))) char smem[];
    float* av = reinterpret_cast<float*>(smem);
    float* kv = av + 128;
    float* qv = kv + 128;
    float* red = qv + 128;
    float* ov = red + 512;
    const int tid = otid(), lane = tid & 63;
    const int h = item & 3, b = item >> 2;
    const long tok = TPROMPT + b;
    const bf16_t* pr = p.PROJ + tok * NINP;
    if (tid < DK) {
        float k; const float lf = log_decay_raw<KIND>(p, l, pr, h, tid, k);
        av[tid] = __expf(lf); kv[tid] = k;
        if (KIND == 0) qv[tid] = siluf_(bf2f(pr[C_QB + h * 128 + tid]));
        else qv[tid] = bf2f(pr[C_QC + h * 64 + tid]) * 0.125f;
    }
    __syncthreads();
    const int e = tid & 127, dg = tid >> 7;
    const float v = bf2f(pr[VOFF + h * 128 + e]);
    const float* S0 = (KIND == 0 ? p.state_hgrn : p.state_gla) + ((long)(l * 32 + b) * 4 + h) * DK * 128;
    float* S1 = p.out + (KIND == 0 ? O_HS : O_GS) + ((long)(l * 32 + b) * 4 + h) * DK * 128;
    float o = 0.f;
    {
        constexpr int ND = DK / 4;
        const int d0 = dg * ND;
        float s0v[ND];
#pragma unroll
        for (int i = 0; i < ND; ++i) s0v[i] = S0[(d0 + i) * 128 + e];
#pragma unroll
        for (int i = 0; i < ND; ++i) {
            const float sn = av[d0 + i] * s0v[i] + kv[d0 + i] * v;
            S1[(d0 + i) * 128 + e] = sn;
            o += qv[d0 + i] * sn;
        }
    }
    red[dg * 128 + e] = o;
    __syncthreads();
    if (tid < 128) ov[tid] = red[tid] + red[128 + tid] + red[256 + tid] + red[384 + tid];
    __syncthreads();
    if (tid < 64) {
        const float x0 = ov[lane], x1 = ov[lane + 64];
        const float ss = wave_sum(x0 * x0 + x1 * x1);
        const float inv = rsqrtf(ss * (1.f / 128.f) + 1e-6f);
        const float* nw = (KIND == 0 ? p.hgrn_nw : p.gla_nw) + (l * 4 + h) * 128;
        const float g0 = bf2f(pr[GOFF + h * 128 + lane]), g1 = bf2f(pr[GOFF + h * 128 + lane + 64]);
        bf16_t* oc = p.OCAT + tok * DM + 1024 + KIND * 512 + h * 128;
        oc[lane] = f2bf(x0 * inv * nw[lane] * siluf_(g0));
        oc[lane + 64] = f2bf(x1 * inv * nw[lane + 64] * siluf_(g1));
    }
    __syncthreads();
}

__device__ __forceinline__ void ph_mix_a(const Params& p, int l) {
    extern __shared__ __attribute__((aligned(16))) char smem[];
    {
        const int tid_ = otid(), wv = tid_ >> 6, ln = tid_ & 63, kt = ln & 31;
        for (int n = blockIdx.x * 8 + wv; n < DM; n += gridDim.x * 8) {
            const float* src = (ln < 32) ? p.CP1 : p.CP2;
            float v = src[((long)l * 32 + kt) * DM + n];
            v = row16_sum(v);
            const float c1s = rdlane(v, 0) + rdlane(v, 16), c2s = rdlane(v, 32) + rdlane(v, 48);
            if (ln == 0) { p.C1[l * DM + n] = c1s; p.C2[l * DM + n] = c2s; }
        }
    }
    for (int it = blockIdx.x; it < 1600; it += gridDim.x) {
        if (it < 64) {
            const int w = __builtin_amdgcn_readfirstlane(otid() >> 6);
            attn_sample_wave(p, l, it * 8 + w, reinterpret_cast<float*>(smem) + w * 512);
            __syncthreads();
        }
        else if (it < 192) rec_sample_item<0>(p, l, it - 64);
        else if (it < 320) rec_sample_item<1>(p, l, it - 192);
        else if (it < 576) attn_prompt_item(p, l, it - 320);
        else if (it < 1088) rec_local_item<0>(p, l, it - 576);
        else rec_local_item<1>(p, l, it - 1088);
    }
}
__device__ __forceinline__ void ph_scan(const Params& p, int l) {
    const long gtid = (long)blockIdx.x * 512 + otid(), gsz = (long)gridDim.x * 512;
    for (long idx = gtid; idx < 262144L + 131072L; idx += gsz) {
        const int kind = idx >= 262144L;
        const long ii = kind ? idx - 262144L : idx;
        const int DK = kind ? 64 : 128;
        const int bh = (int)(ii / (DK * 128)), rem = (int)(ii % (DK * 128)), d = rem & (DK - 1), e = rem / DK;
        bf16_t* __restrict__ st = (kind ? p.GST : p.HST) + (long)bh * 33 * DK * 128 + rem;
        const float* __restrict__ dg = (kind ? p.GD : p.HD) + (long)bh * 32 * DK + d;
        const long cs = (long)DK * 128;
        float lsv[32], dv[32];
#pragma unroll
        for (int c = 0; c < 32; ++c) { lsv[c] = bf2f(st[(c + 1) * cs]); dv[c] = dg[c * DK]; }
        float s = 0.f; st[0] = 0;
#pragma unroll
        for (int c = 0; c < 32; ++c) { s = dv[c] * s + lsv[c]; st[(c + 1) * cs] = f2bf(s); }
        const int b = bh >> 2, h = bh & 3;
        p.out[(kind ? O_GP : O_HP) + ((long)(l * 4 + b) * 4 + h) * DK * 128 + d * 128 + e] = s;
    }
}
__device__ __forceinline__ void ph_mix_b(const Params& p, int l) {
    for (int it = blockIdx.x; it < 1024; it += gridDim.x) {
        if (it < 512) rec_out_item<0>(p, l, it);
        else rec_out_item<1>(p, l, it - 512);
    }
}

typedef float float2v __attribute__((ext_vector_type(2)));
typedef _Float16 half2v __attribute__((ext_vector_type(2)));
__device__ __forceinline__ unsigned fkey(float f) { const unsigned k = __float_as_uint(f); return (k & 0x80000000u) ? ~k : (k | 0x80000000u); }
__device__ __forceinline__ int mbcnt64(unsigned long long m) {
    return (int)__builtin_amdgcn_mbcnt_hi((unsigned)(m >> 32), __builtin_amdgcn_mbcnt_lo((unsigned)m, 0u));
}
template <int NV>
__device__ __forceinline__ void select16(const unsigned (&k)[NV], bool (&keep)[NV], int (&pos)[NV]) {
    unsigned km = k[0];
#pragma unroll
    for (int v = 1; v < NV; ++v) km = km > k[v] ? km : k[v];
    km = wave_max_u32(km);
    unsigned T = km & 0xFF800000u;
    int c0 = 0;
#pragma unroll 1
    for (;;) {
        c0 = 0;
#pragma unroll
        for (int v = 0; v < NV; ++v) c0 += __popcll(__ballot(k[v] >= T));
        if (c0 >= 16 || T < 0x00800000u) break;
        T -= 0x00800000u;
    }
    if (c0 < 16) T = 0u;
    bool exact = (c0 == 16);
    if (!exact) {
        for (int bit = 22; bit >= 0; --bit) {
            const unsigned trial = T | (1u << bit);
            int c = 0;
#pragma unroll
            for (int v = 0; v < NV; ++v) c += __popcll(__ballot(k[v] >= trial));
            if (c >= 16) { T = trial; if (c == 16) { exact = true; break; } }
        }
    }
    if (exact) {
        int pbase = 0;
#pragma unroll
        for (int v = 0; v < NV; ++v) {
            keep[v] = k[v] >= T;
            const unsigned long long K = __ballot(keep[v]);
            pos[v] = pbase + mbcnt64(K);
            pbase += __popcll(K);
        }
        return;
    }
    int g = 0;
#pragma unroll
    for (int v = 0; v < NV; ++v) g += __popcll(__ballot(k[v] > T));
    const int need = 16 - g;
    int ebase = 0, pbase = 0;
#pragma unroll
    for (int v = 0; v < NV; ++v) {
        const unsigned long long e = __ballot(k[v] == T);
        const int pe = ebase + mbcnt64(e);
        keep[v] = (k[v] > T) || ((k[v] == T) && (pe < need));
        ebase += __popcll(e);
        const unsigned long long K = __ballot(keep[v]);
        pos[v] = pbase + mbcnt64(K);
        pbase += __popcll(K);
    }
}
constexpr int PW_IDX = 0, PW_GATE = 128, PW_USC = 256, PW_VSC = 384, PW_SLOT = 512, PW_WW = 1024, PW_TKF = 1152, PW_TKI = 1216, PW_TR = 1280, PW_SC = 1792, PW_WORDS = 2816;

template <bool SCALES>
__device__ __forceinline__ void peer_select_head(const Params& p, int l, int lane, const float (&sv)[2][2], float* wl, float* sl, int slot) {
    float* tkf = wl + PW_TKF; int* tki = reinterpret_cast<int*>(wl) + PW_TKI;
#pragma unroll
    for (int p2 = 0; p2 < 2; ++p2) {
        const unsigned k[2] = {fkey(sv[p2][0]), fkey(sv[p2][1])};
        bool keep[2]; int pos[2];
        select16<2>(k, keep, pos);
        if (keep[0]) { tkf[p2 * 16 + pos[0]] = sv[p2][0]; tki[p2 * 16 + pos[0]] = lane; }
        if (keep[1]) { tkf[p2 * 16 + pos[1]] = sv[p2][1]; tki[p2 * 16 + pos[1]] = lane + 64; }
    }
    wave_lds_fence();
    const int i = lane >> 2, jb = (lane & 3) * 4;
    const float a = tkf[i];
    float c[4]; unsigned ck[4];
#pragma unroll
    for (int k = 0; k < 4; ++k) { c[k] = a + tkf[16 + jb + k]; ck[k] = fkey(c[k]); }
    bool keep4[4]; int pos4[4];
    select16<4>(ck, keep4, pos4);
    const int ia = tki[i];
#pragma unroll
    for (int k = 0; k < 4; ++k) if (keep4[k]) { tkf[32 + pos4[k]] = c[k]; tki[32 + pos4[k]] = ia * 128 + tki[16 + jb + k]; }
    wave_lds_fence();
    const float best = (lane < 16) ? tkf[32 + lane] : -3.0e38f;
    const float mx = wave_max(best);
    const float ex = (lane < 16) ? __expf(best - mx) : 0.f;
    const float sm = wave_sum(ex);
    if (lane < 16) {
        const int ei = tki[32 + lane];
        reinterpret_cast<int*>(sl)[PW_IDX + slot * 16 + lane] = ei;
        sl[PW_GATE + slot * 16 + lane] = ex / sm;
        if (SCALES && PEER_U_FMT != 4) sl[PW_USC + slot * 16 + lane] = p.Usc[l * NEXP + ei];
        if (SCALES && PEER_V_FMT != 4) sl[PW_VSC + slot * 16 + lane] = p.Vsc[l * NEXP + ei];
    }
    wave_lds_fence();
}

template <int F> struct RowFmt;
template <> struct RowFmt<8> {
    static constexpr int ROWB = 2048, NB = 8;
    struct Regs { uint4 a, b; };
    static __device__ __forceinline__ int col(int lane, int m) { return (m >> 3) * 1024 + lane * 16 + (m & 7) * 2; }
    static __device__ __forceinline__ Regs load(const unsigned char* row, int lane) {
        Regs r; r.a = *reinterpret_cast<const uint4*>(row + lane * 16); r.b = *reinterpret_cast<const uint4*>(row + 1024 + lane * 16); return r;
    }
    static __device__ __forceinline__ void pin(Regs& r) {
        asm volatile("" : "+v"(r.a.x), "+v"(r.a.y), "+v"(r.a.z), "+v"(r.a.w), "+v"(r.b.x), "+v"(r.b.y), "+v"(r.b.z), "+v"(r.b.w));
    }
    template <class FN> static __device__ __forceinline__ void foreach(const Regs& r, FN&& fn) {
        const unsigned d[8] = {r.a.x, r.a.y, r.a.z, r.a.w, r.b.x, r.b.y, r.b.z, r.b.w};
#pragma unroll
        for (int w = 0; w < 8; ++w) {
            fn(w * 2, __builtin_amdgcn_cvt_pk_f32_fp8((int)d[w], false));
            fn(w * 2 + 1, __builtin_amdgcn_cvt_pk_f32_fp8((int)d[w], true));
        }
    }
};
template <> struct RowFmt<4> {
    static constexpr int ROWB = 1088, NB = 16;
    struct Regs { uint4 a; unsigned sc; };
    static __device__ __forceinline__ int col(int lane, int m) { return lane * 32 + m * 2; }
    static __device__ __forceinline__ Regs load(const unsigned char* row, int lane) {
        Regs r; r.a = *reinterpret_cast<const uint4*>(row + lane * 16); r.sc = row[1024 + lane]; return r;
    }
    static __device__ __forceinline__ void pin(Regs& r) {
        asm volatile("" : "+v"(r.a.x), "+v"(r.a.y), "+v"(r.a.z), "+v"(r.a.w), "+v"(r.sc));
    }
    template <class FN> static __device__ __forceinline__ void foreach(const Regs& r, FN&& fn) {
        const unsigned d[4] = {r.a.x, r.a.y, r.a.z, r.a.w};
        const float s = __uint_as_float(r.sc << 23);
#pragma unroll
        for (int w = 0; w < 4; ++w) {
            fn(w * 4 + 0, __builtin_amdgcn_cvt_scalef32_pk_f32_fp4(d[w], s, 0));
            fn(w * 4 + 1, __builtin_amdgcn_cvt_scalef32_pk_f32_fp4(d[w], s, 1));
            fn(w * 4 + 2, __builtin_amdgcn_cvt_scalef32_pk_f32_fp4(d[w], s, 2));
            fn(w * 4 + 3, __builtin_amdgcn_cvt_scalef32_pk_f32_fp4(d[w], s, 3));
        }
    }
};
template <> struct RowFmt<5> {
    static constexpr int ROWB = 1024, NB = 16;
    struct Regs { uint4 a; };
    static __device__ __forceinline__ int col(int lane, int m) { return lane * 32 + m * 2; }
    static __device__ __forceinline__ Regs load(const unsigned char* row, int lane) {
        Regs r; r.a = *reinterpret_cast<const uint4*>(row + lane * 16); return r;
    }
    static __device__ __forceinline__ void pin(Regs& r) { asm volatile("" : "+v"(r.a.x), "+v"(r.a.y), "+v"(r.a.z), "+v"(r.a.w)); }
    template <class FN> static __device__ __forceinline__ void foreach(const Regs& r, FN&& fn) {
        const unsigned d[4] = {r.a.x, r.a.y, r.a.z, r.a.w};
#pragma unroll
        for (int w = 0; w < 4; ++w) {
            fn(w * 4 + 0, __builtin_amdgcn_cvt_scalef32_pk_f32_fp4(d[w], 1.0f, 0));
            fn(w * 4 + 1, __builtin_amdgcn_cvt_scalef32_pk_f32_fp4(d[w], 1.0f, 1));
            fn(w * 4 + 2, __builtin_amdgcn_cvt_scalef32_pk_f32_fp4(d[w], 1.0f, 2));
            fn(w * 4 + 3, __builtin_amdgcn_cvt_scalef32_pk_f32_fp4(d[w], 1.0f, 3));
        }
    }
    template <class FN> static __device__ __forceinline__ void foreach_h(const Regs& r, FN&& fn) {
        const unsigned d[4] = {r.a.x, r.a.y, r.a.z, r.a.w};
#pragma unroll
        for (int w = 0; w < 4; ++w) {
            fn(w * 4 + 0, __builtin_amdgcn_cvt_scalef32_pk_f16_fp4(d[w], 1.0f, 0));
            fn(w * 4 + 1, __builtin_amdgcn_cvt_scalef32_pk_f16_fp4(d[w], 1.0f, 1));
            fn(w * 4 + 2, __builtin_amdgcn_cvt_scalef32_pk_f16_fp4(d[w], 1.0f, 2));
            fn(w * 4 + 3, __builtin_amdgcn_cvt_scalef32_pk_f16_fp4(d[w], 1.0f, 3));
        }
    }
};
template <int F>
__device__ __forceinline__ void peer_load_vec(const Params& p, int l, int t, int lane, float2v (&x2)[16]) {
    const bf16_t* z = p.X1bf + (long)t * DM;
    const float* g = p.ln1_g + l * DM; const float* bb = p.ln1_b + l * DM;
    uint2 zr[8]; float4 gg[8], be[8];
#pragma unroll
    for (int q = 0; q < 8; ++q) {
        const int c = RowFmt<F>::col(lane, 2 * q);
        zr[q] = *reinterpret_cast<const uint2*>(z + c);
        gg[q] = *reinterpret_cast<const float4*>(g + c);
        be[q] = *reinterpret_cast<const float4*>(bb + c);
    }
    float s1 = 0.f, s2 = 0.f;
    if (t < TPROMPT) {
#pragma unroll
        for (int q = 0; q < 8; ++q) { const float2 pq = *reinterpret_cast<const float2*>(p.ZS + (((long)l * TPROMPT + t) * 8 + q) * 2); s1 += pq.x; s2 += pq.y; }
    } else {
#pragma unroll
        for (int q = 0; q < 8; ++q) {
            const float f0 = __uint_as_float(zr[q].x << 16), f1 = __uint_as_float(zr[q].x & 0xffff0000u);
            const float f2 = __uint_as_float(zr[q].y << 16), f3 = __uint_as_float(zr[q].y & 0xffff0000u);
            s1 += (f0 + f1) + (f2 + f3); s2 += (f0 * f0 + f1 * f1) + (f2 * f2 + f3 * f3);
        }
        s1 = wave_sum(s1); s2 = wave_sum(s2);
    }
    const float mean = s1 * (1.f / DM), rstd = rsqrtf(fmaxf(s2 * (1.f / DM) - mean * mean, 0.f) + 1e-5f);
#pragma unroll
    for (int q = 0; q < 8; ++q) {
        const float4 a = make_float4(__uint_as_float(zr[q].x << 16), __uint_as_float(zr[q].x & 0xffff0000u), __uint_as_float(zr[q].y << 16), __uint_as_float(zr[q].y & 0xffff0000u));
        x2[2 * q] = float2v{(a.x - mean) * rstd * gg[q].x + be[q].x, (a.y - mean) * rstd * gg[q].y + be[q].y};
        x2[2 * q + 1] = float2v{(a.z - mean) * rstd * gg[q].z + be[q].z, (a.w - mean) * rstd * gg[q].w + be[q].w};
    }
}

template <int NE, class HOOK>
__device__ __forceinline__ void peer_gather(const Params& p, int l, int lane, float* wl, const float* sl, const float2v (&x2)[16], float2v (&acc)[16], half2v (&x2h)[16], HOOK&& hook) {
    static_assert(PEER_U_FMT == PEER_V_FMT, "pipelined gather assumes one row format");
    using FU = RowFmt<PEER_U_FMT>; using FV = RowFmt<PEER_V_FMT>;
    typedef typename FU::Regs Regs;
    const int* idx = reinterpret_cast<const int*>(sl) + PW_IDX;
    const float* gate = sl + PW_GATE; const float* usc = sl + PW_USC; const float* vsc = sl + PW_VSC; float* ww = wl + PW_WW;
    float* tr = wl + PW_TR;
    const unsigned char* Ul = p.U8 + (long)l * NEXP * FU::ROWB;
    const unsigned char* Vl = p.V8 + (long)l * NEXP * FV::ROWB;
    constexpr int NB = FU::NB / 2, NBAT = NE / NB, NR = 2 * NB;
    Regs bufA[NB], bufB[NB];
#if PEER_F16
    half2v acch[16];
#pragma unroll
    for (int m = 0; m < 16; ++m) {
        x2h[m] = __builtin_convertvector(x2[m], half2v);
        unsigned xr = __builtin_bit_cast(unsigned, x2h[m]); asm volatile("" : "+v"(xr)); x2h[m] = __builtin_bit_cast(half2v, xr);
        acch[m] = half2v{(_Float16)0.f, (_Float16)0.f};
    }
    float wscale = 1.f;
#endif
    auto load = [&](Regs (&buf)[NB], const unsigned char* tab, int k0) {
#pragma unroll
        for (int e = 0; e < NB; ++e) {
            const int ex = __builtin_amdgcn_readfirstlane(idx[k0 + e]);
            buf[e] = FU::load(tab + (long)ex * FU::ROWB, lane);
        }
    };
    auto compU = [&](Regs (&buf)[NB], int g) {
#pragma unroll
        for (int e = 0; e < NB; ++e) {
            FU::pin(buf[e]);
#if PEER_F16
            float sa = 0.f, sb = 0.f;
            FU::foreach_h(buf[e], [&](int m, half2v f) { if (m & 1) sb = __builtin_amdgcn_fdot2(f, x2h[m], sb, false); else sa = __builtin_amdgcn_fdot2(f, x2h[m], sa, false); });
            tr[((g & 1) * NB + e) * 65 + lane] = sa + sb;
#else
            float2v s2 = {0.f, 0.f};
            FU::foreach(buf[e], [&](int m, float2v f) { s2 = f * x2[m] + s2; });
            tr[((g & 1) * NB + e) * 65 + lane] = s2.x + s2.y;
#endif
            __builtin_amdgcn_sched_barrier(0);
        }
        if (g & 1) {
            wave_lds_fence();
            const int k0 = (g - 1) * NB;
            const int e = lane & (NR - 1), seg = lane / NR;
            float hs = 0.f;
#pragma unroll
            for (int i = 0; i < NR; ++i) hs += tr[e * 65 + seg * NR + i];
#pragma unroll
            for (int d = NR; d < 64; d <<= 1) hs += __shfl_xor(hs, d);
            if (PEER_U_FMT != 4) hs *= usc[k0 + e];
            float wv = gate[k0 + e] * geluf_(hs);
            if (PEER_V_FMT != 4) wv *= vsc[k0 + e];
            if (seg == 0) ww[k0 + e] = wv;
            wave_lds_fence();
        }
    };
    auto compV = [&](Regs (&buf)[NB], int g) {
        const int k0 = g * NB;
#pragma unroll
        for (int e = 0; e < NB; ++e) {
            FV::pin(buf[e]);
#if PEER_F16
            const _Float16 wh = (_Float16)(ww[k0 + e] * wscale);
            const half2v w2 = {wh, wh};
            FV::foreach_h(buf[e], [&](int m, half2v f) { acch[m] = f * w2 + acch[m]; });
#else
            const float wv = ww[k0 + e];
            const float2v w2 = {wv, wv};
            FV::foreach(buf[e], [&](int m, float2v f) { acc[m] = f * w2 + acc[m]; });
#endif
            __builtin_amdgcn_sched_barrier(0);
        }
    };
    Regs bufC[NB];
#define PG_SB __builtin_amdgcn_sched_barrier(0)
#if PEER_F16
#define PEER_WSCALE() do { float wm = (NE == 128) ? fmaxf(fabsf(ww[lane]), fabsf(ww[lane + 64])) : ((lane < NE) ? fabsf(ww[lane & (NE - 1)]) : 0.f); wm = wave_max(wm); \
                           wscale = wm > 0.f ? 64.f / wm : 1.f; } while (0)
#else
#define PEER_WSCALE() do { } while (0)
#endif
#if PEER_MFMA_U
    {
        typedef int int8v __attribute__((ext_vector_type(8)));
        unsigned char* xq = reinterpret_cast<unsigned char*>(wl + PW_TR);
        float am = 0.f;
#pragma unroll
        for (int m = 0; m < 16; ++m) am = fmaxf(am, fmaxf(fabsf(x2[m].x), fabsf(x2[m].y)));
        am = wave_max(am);
        const float sx = am > 0.f ? 6.f / am : 1.f, isx = 1.f / sx;
        {
            unsigned q1[4], q2[4];
#pragma unroll
            for (int d = 0; d < 4; ++d) {
                unsigned p1 = 0u, p2 = 0u;
#define XQ_STEP(bs) do { const float a0 = x2[d * 4 + bs].x * sx, a1 = x2[d * 4 + bs].y * sx; \
                    p1 = __builtin_amdgcn_cvt_scalef32_pk_fp4_f32(p1, a0, a1, 1.0f, bs); \
                    const float2v back = __builtin_amdgcn_cvt_scalef32_pk_f32_fp4(p1, 1.0f, bs); \
                    p2 = __builtin_amdgcn_cvt_scalef32_pk_fp4_f32(p2, (a0 - back.x) * 6.f, (a1 - back.y) * 6.f, 1.0f, bs); } while (0)
                XQ_STEP(0); XQ_STEP(1); XQ_STEP(2); XQ_STEP(3);
#undef XQ_STEP
                q1[d] = p1; q2[d] = p2;
            }
            *reinterpret_cast<uint4*>(xq + lane * 16) = make_uint4(q1[0], q1[1], q1[2], q1[3]);
            *reinterpret_cast<uint4*>(xq + 1024 + lane * 16) = make_uint4(q2[0], q2[1], q2[2], q2[3]);
        }
        wave_lds_fence();
        const int ri = lane & 15, kq = lane >> 4;
        constexpr int NG = NE / 16;
        uint4 ga[16], gb[16];
        auto gload = [&](uint4 (&buf)[16], int g) {
            const unsigned char* row = Ul + (long)idx[g * 16 + ri] * FU::ROWB + kq * 16;
#pragma unroll
            for (int s_ = 0; s_ < 16; ++s_) buf[s_] = *reinterpret_cast<const uint4*>(row + s_ * 64);
        };
        const int bsel = (ri == 1) ? 1024 : 0;
        auto gepi = [&](const f32x4& a4, int g) {
#pragma unroll
            for (int rg = 0; rg < 4; ++rg) {
                const int e = g * 16 + kq * 4 + rg;
                const float lo = dpp_mov<0xF5>(a4[rg]);
                float hs = (a4[rg] + lo * (1.f / 6.f)) * isx;
                if (PEER_U_FMT != 4) hs *= usc[e];
                float wv = gate[e] * geluf_(hs);
                if (PEER_V_FMT != 4) wv *= vsc[e];
                if (ri == 0) ww[e] = wv;
            }
        };
        auto gcomp2 = [&](uint4 (&bA)[16], uint4 (&bB)[16], int g) {
            uint4 bf[16];
#pragma unroll
            for (int s_ = 0; s_ < 16; ++s_) bf[s_] = *reinterpret_cast<const uint4*>(xq + bsel + s_ * 64 + kq * 16);
            f32x4 accA = f32x4{0.f, 0.f, 0.f, 0.f}, accB = f32x4{0.f, 0.f, 0.f, 0.f};
#pragma unroll
            for (int s_ = 0; s_ < 16; ++s_) {
                const int8v Bv = {(int)bf[s_].x, (int)bf[s_].y, (int)bf[s_].z, (int)bf[s_].w, 0, 0, 0, 0};
                const int8v A0 = {(int)bA[s_].x, (int)bA[s_].y, (int)bA[s_].z, (int)bA[s_].w, 0, 0, 0, 0};
                accA = __builtin_amdgcn_mfma_scale_f32_16x16x128_f8f6f4(A0, Bv, accA, 4, 4, 0, 127, 0, 127);
                if (NG > 1) {
                    const int8v A1 = {(int)bB[s_].x, (int)bB[s_].y, (int)bB[s_].z, (int)bB[s_].w, 0, 0, 0, 0};
                    accB = __builtin_amdgcn_mfma_scale_f32_16x16x128_f8f6f4(A1, Bv, accB, 4, 4, 0, 127, 0, 127);
                }
            }
            gepi(accA, g);
            if (NG > 1) gepi(accB, g + 1);
        };
#pragma unroll 1
        for (int g = 0; g < NG; g += 2) {
            gload(ga, g); if (NG > 1) gload(gb, g + 1);
            PG_SB; if (NE == 128) { hook(g >> 1); PG_SB; } else { hook(0); PG_SB; }
            gcomp2(ga, gb, g); PG_SB;
        }
        wave_lds_fence();
    }
    {
        Regs bufD[NB];
        PEER_WSCALE();
        if (NBAT == 16) {
#pragma unroll 1
            for (int G = 0; G < 16; G += 4) {
                load(bufA, Vl, G * NB); load(bufB, Vl, (G + 1) * NB); load(bufC, Vl, (G + 2) * NB); load(bufD, Vl, (G + 3) * NB);
                PG_SB; hook(4 + (G >> 2)); PG_SB;
                compV(bufA, G); PG_SB; compV(bufB, G + 1); PG_SB; compV(bufC, G + 2); PG_SB; compV(bufD, G + 3); PG_SB;
            }
        } else {
            load(bufA, Vl, 0); load(bufB, Vl, NB); PG_SB;
            hook(1); PG_SB;
            compV(bufA, 0); PG_SB; compV(bufB, 1); PG_SB;
        }
    }
#else
    auto loadG = [&](Regs (&buf)[NB], int G) {
        if (G < NBAT) load(buf, Ul, G * NB); else if (G < 2 * NBAT) load(buf, Vl, (G - NBAT) * NB);
    };
#define PG_U(buf, nxt, G) do { loadG(nxt, (G) + 2); PG_SB; compU(buf, (G)); PG_SB; } while (0)
#define PG_V(buf, nxt, G) do { loadG(nxt, (G) + 2); PG_SB; compV(buf, (G) - NBAT); PG_SB; } while (0)
    if (NBAT == 16) {
        loadG(bufA, 0); loadG(bufB, 1); PG_SB;
#pragma unroll 1
        for (int G = 0; G < 15; G += 3) { PG_U(bufA, bufC, G); PG_U(bufB, bufA, G + 1); PG_U(bufC, bufB, G + 2); }
        PG_U(bufA, bufC, 15);
        PEER_WSCALE();
        PG_V(bufB, bufA, 16); PG_V(bufC, bufB, 17);
#pragma unroll 1
        for (int G = 18; G < 30; G += 3) { PG_V(bufA, bufC, G); PG_V(bufB, bufA, G + 1); PG_V(bufC, bufB, G + 2); }
        PG_V(bufA, bufC, 30); PG_V(bufB, bufA, 31);
    } else {
        loadG(bufA, 0); loadG(bufB, 1); PG_SB;
        PG_U(bufA, bufC, 0); PG_U(bufB, bufA, 1); PEER_WSCALE(); PG_V(bufC, bufB, 2); PG_V(bufA, bufC, 3);
    }
#undef PG_U
#undef PG_V
#endif
#undef PG_SB
#undef PEER_WSCALE
#if PEER_F16
    {
        const float inv = 1.f / wscale;
#pragma unroll
        for (int m = 0; m < 16; ++m) acc[m] = float2v{(float)acch[m].x * inv, (float)acch[m].y * inv};
    }
#endif
}
__device__ __forceinline__ float* peer_out_row(const Params& p, int l, int t) {
    if (l == 3) return (t < TPROMPT) ? (p.out + O_YP + (long)t * DM) : (p.out + O_YS + (long)(t - TPROMPT) * DM);
    return p.out;
}
__device__ __forceinline__ void peer_stage_scores(const Params& p, int t, float* wl) {
    const int lane = otid() & 63;
    const uint4* src = reinterpret_cast<const uint4*>(reinterpret_cast<const bf16_t*>(p.SC) + (long)t * DM);
    const uint4 v0 = src[lane], v1 = src[64 + lane], v2 = src[128 + lane], v3 = src[192 + lane];
    __builtin_amdgcn_sched_barrier(0);
    uint4* dst = reinterpret_cast<uint4*>(wl + PW_SC);
    dst[lane] = v0; dst[64 + lane] = v1; dst[128 + lane] = v2; dst[192 + lane] = v3;
    wave_lds_fence();
}
__device__ __forceinline__ void peer_select_slice(const Params& p, int l, float* wl, float* sl, int h) {
    const int lane = otid() & 63;
    const bf16_t* scl = reinterpret_cast<const bf16_t*>(wl + PW_SC);
    float sv[2][2];
#pragma unroll
    for (int p2 = 0; p2 < 2; ++p2) { sv[p2][0] = bf2f(scl[(h * 2 + p2) * 128 + lane]); sv[p2][1] = bf2f(scl[(h * 2 + p2) * 128 + 64 + lane]); }
    peer_select_head<false>(p, l, lane, sv, wl, sl, h);
}
template <class HOOK>
__device__ __forceinline__ void peer_token_gather(const Params& p, int l, int t, int tn, float* wl, float* sl, HOOK&& hook) {
    using FV = RowFmt<PEER_V_FMT>;
    const int lane = otid() & 63;
    const int ei0 = reinterpret_cast<const int*>(sl)[PW_IDX + lane], ei1 = reinterpret_cast<const int*>(sl)[PW_IDX + 64 + lane];
    const float us0 = p.Usc[l * NEXP + ei0], vs0 = p.Vsc[l * NEXP + ei0], us1 = p.Usc[l * NEXP + ei1], vs1 = p.Vsc[l * NEXP + ei1];
    const uint4* scsrc = reinterpret_cast<const uint4*>(reinterpret_cast<const bf16_t*>(p.SC) + (long)(tn >= 0 ? tn : t) * DM);
    const uint4 scv0 = scsrc[lane], scv1 = scsrc[64 + lane], scv2 = scsrc[128 + lane], scv3 = scsrc[192 + lane];
    float2v x2[16], acc[16];
    peer_load_vec<PEER_U_FMT>(p, l, t, lane, x2);
    sl[PW_USC + lane] = us0; sl[PW_VSC + lane] = vs0; sl[PW_USC + 64 + lane] = us1; sl[PW_VSC + 64 + lane] = vs1;
    { uint4* scd = reinterpret_cast<uint4*>(wl + PW_SC); scd[lane] = scv0; scd[64 + lane] = scv1; scd[128 + lane] = scv2; scd[192 + lane] = scv3; }
#pragma unroll
    for (int i = 0; i < 16; ++i) acc[i] = float2v{0.f, 0.f};
    wave_lds_fence();
    half2v xh[16];
    peer_gather<128>(p, l, lane, wl, sl, x2, acc, xh, hook);
    if (PEER_U_FMT != PEER_V_FMT) peer_load_vec<PEER_V_FMT>(p, l, t, lane, x2);
    const float* g = p.ln2_g + l * DM; const float* bb = p.ln2_b + l * DM;
    float4 g2v[8], b2v[8];
#pragma unroll
    for (int q8 = 0; q8 < 4; ++q8)
#pragma unroll
        for (int hf = 0; hf < 2; ++hf) {
            const int col = FV::col(lane, 4 * q8);
            g2v[q8 * 2 + hf] = *reinterpret_cast<const float4*>(g + col + hf * 4);
            b2v[q8 * 2 + hf] = *reinterpret_cast<const float4*>(bb + col + hf * 4);
        }
    float s = 0.f;
#pragma unroll
    for (int i = 0; i < 16; ++i) { acc[i] = float2v{(float)xh[i].x, (float)xh[i].y} * float2v{ALPHA_F, ALPHA_F} + acc[i]; s += acc[i].x + acc[i].y; }
    const float mean = wave_sum(s) * (1.f / DM);
    float q = 0.f;
#pragma unroll
    for (int i = 0; i < 16; ++i) { const float d0 = acc[i].x - mean, d1 = acc[i].y - mean; q += d0 * d0 + d1 * d1; }
    const float rstd = rsqrtf(wave_sum(q) * (1.f / DM) + 1e-5f);
    float* yo = peer_out_row(p, l, t);
#pragma unroll
    for (int q8 = 0; q8 < 4; ++q8) {
        const int col = FV::col(lane, 4 * q8);
        float y[8];
#pragma unroll
        for (int hf = 0; hf < 2; ++hf) {
            const float4 gg = g2v[q8 * 2 + hf];
            const float4 be = b2v[q8 * 2 + hf];
            y[hf * 4 + 0] = (acc[4 * q8 + 2 * hf].x - mean) * rstd * gg.x + be.x;
            y[hf * 4 + 1] = (acc[4 * q8 + 2 * hf].y - mean) * rstd * gg.y + be.y;
            y[hf * 4 + 2] = (acc[4 * q8 + 2 * hf + 1].x - mean) * rstd * gg.z + be.z;
            y[hf * 4 + 3] = (acc[4 * q8 + 2 * hf + 1].y - mean) * rstd * gg.w + be.w;
            if (l == 3) *reinterpret_cast<float4*>(yo + col + hf * 4) = make_float4(y[hf * 4], y[hf * 4 + 1], y[hf * 4 + 2], y[hf * 4 + 3]);
        }
        if (l < 3) *reinterpret_cast<uint4*>(p.Xbf + (long)t * DM + col) = pack8(y);
    }
    wave_lds_fence();
}
template <class HOOK>
__device__ __forceinline__ void peer_token_block(const Params& p, int l, int t, float* wl, float* red  , float* stat  , HOOK&& hook) {
    const int tid = otid(), lane = tid & 63, w = __builtin_amdgcn_readfirstlane(tid >> 6);
    float sv[2][2];
    {
        float* scs = wl + PW_TR;
        const bf16_t* qrow = p.Q + (long)t * DM + w * 256;
        const int r = lane & 15, q4 = lane >> 4;
#pragma unroll
        for (int p2 = 0; p2 < 2; ++p2) {
            const bf16_t* kb = p.keys + (((long)l * 16 + w * 2 + p2) * 128 + r) * 128 + q4 * 8;
            bf16x8 kfr[8][4], qfr[4];
#pragma unroll
            for (int ks = 0; ks < 4; ++ks) qfr[ks] = *reinterpret_cast<const bf16x8*>(qrow + p2 * 128 + ks * 32 + q4 * 8);
#pragma unroll
            for (int tt = 0; tt < 8; ++tt)
#pragma unroll
                for (int ks = 0; ks < 4; ++ks) kfr[tt][ks] = *reinterpret_cast<const bf16x8*>(kb + (long)tt * 16 * 128 + ks * 32);
            __builtin_amdgcn_sched_barrier(0);
            hook(2 * p2); hook(2 * p2 + 1);
            __builtin_amdgcn_sched_barrier(0);
#pragma unroll
            for (int tt = 0; tt < 8; ++tt) {
                f32x4 a4 = f32x4{0.f, 0.f, 0.f, 0.f};
#pragma unroll
                for (int ks = 0; ks < 4; ++ks) a4 = mfma16(kfr[tt][ks], qfr[ks], a4);
                if (r == 0) *reinterpret_cast<f32x4*>(scs + tt * 16 + q4 * 4) = a4;
            }
            wave_lds_fence();
            sv[p2][0] = scs[lane]; sv[p2][1] = scs[lane + 64];
            wave_lds_fence();
        }
    }
    float* slb = wl + PW_SLOT;
    peer_select_head<true>(p, l, lane, sv, wl, slb, 0);
    float2v x2[16], acc[16];
    peer_load_vec<PEER_U_FMT>(p, l, t, lane, x2);
#pragma unroll
    for (int i = 0; i < 16; ++i) acc[i] = float2v{0.f, 0.f};
    half2v xh[16];
    peer_gather<16>(p, l, lane, wl, slb, x2, acc, xh, [&](int k) { hook(4 + k); });
#pragma unroll
    for (int m = 0; m < 16; ++m) *reinterpret_cast<float2v*>(red + w * DM + RowFmt<PEER_V_FMT>::col(lane, m)) = acc[m];
    __syncthreads();
    const int col = tid * 4;
    float4 xv;
    {
        const uint2 zq = *reinterpret_cast<const uint2*>(p.X1bf + (long)t * DM + col);
        const float4 zz = make_float4(__uint_as_float(zq.x << 16), __uint_as_float(zq.x & 0xffff0000u), __uint_as_float(zq.y << 16), __uint_as_float(zq.y & 0xffff0000u));
        const float4 g1 = *reinterpret_cast<const float4*>(p.ln1_g + l * DM + col), b1 = *reinterpret_cast<const float4*>(p.ln1_b + l * DM + col);
        __builtin_amdgcn_sched_barrier(0);
        hook(6); hook(7);
        __builtin_amdgcn_sched_barrier(0);
        const float ps1 = wave_sum(zz.x + zz.y + zz.z + zz.w), ps2 = wave_sum(zz.x * zz.x + zz.y * zz.y + zz.z * zz.z + zz.w * zz.w);
        if (lane == 0) { stat[16 + w] = ps1; stat[24 + w] = ps2; }
        __syncthreads();
        float s1 = 0.f, s2 = 0.f;
#pragma unroll
        for (int i = 0; i < 8; ++i) { s1 += stat[16 + i]; s2 += stat[24 + i]; }
        const float mean1 = s1 * (1.f / DM), rstd1 = rsqrtf(fmaxf(s2 * (1.f / DM) - mean1 * mean1, 0.f) + 1e-5f);
        xv.x = (zz.x - mean1) * rstd1 * g1.x + b1.x; xv.y = (zz.y - mean1) * rstd1 * g1.y + b1.y;
        xv.z = (zz.z - mean1) * rstd1 * g1.z + b1.z; xv.w = (zz.w - mean1) * rstd1 * g1.w + b1.w;
    }
    float z0 = ALPHA_F * xv.x, z1 = ALPHA_F * xv.y, z2 = ALPHA_F * xv.z, z3 = ALPHA_F * xv.w;
#pragma unroll
    for (int ww_ = 0; ww_ < 8; ++ww_) {
        const float4 r = *reinterpret_cast<const float4*>(red + ww_ * DM + col);
        z0 += r.x; z1 += r.y; z2 += r.z; z3 += r.w;
    }
    const float ps = wave_sum(z0 + z1 + z2 + z3);
    if (lane == 0) stat[w] = ps;
    __syncthreads();
    float tot = 0.f;
#pragma unroll
    for (int i = 0; i < 8; ++i) tot += stat[i];
    const float mean = tot * (1.f / DM);
    const float d0 = z0 - mean, d1 = z1 - mean, d2 = z2 - mean, d3 = z3 - mean;
    const float pq = wave_sum(d0 * d0 + d1 * d1 + d2 * d2 + d3 * d3);
    if (lane == 0) stat[8 + w] = pq;
    __syncthreads();
    float totq = 0.f;
#pragma unroll
    for (int i = 0; i < 8; ++i) totq += stat[8 + i];
    const float rstd = rsqrtf(totq * (1.f / DM) + 1e-5f);
    const float4 gg = *reinterpret_cast<const float4*>(p.ln2_g + l * DM + col);
    const float4 be = *reinterpret_cast<const float4*>(p.ln2_b + l * DM + col);
    const float y0 = d0 * rstd * gg.x + be.x, y1 = d1 * rstd * gg.y + be.y, y2 = d2 * rstd * gg.z + be.z, y3 = d3 * rstd * gg.w + be.w;
    float* yo = peer_out_row(p, l, t);
    if (l == 3) *reinterpret_cast<float4*>(yo + col) = make_float4(y0, y1, y2, y3);
    if (l < 3) { uint2 pk; pk.x = pack2(y0, y1); pk.y = pack2(y2, y3); *reinterpret_cast<uint2*>(p.Xbf + (long)t * DM + col) = pk; }
    __syncthreads();
}
__device__ __forceinline__ void ph_peer(const Params& p, int l) {
    extern __shared__ __attribute__((aligned(16))) char smem[];
    const int w = __builtin_amdgcn_readfirstlane(otid() >> 6);
    float* wl = reinterpret_cast<float*>(smem) + w * PW_WORDS;
    float* red = reinterpret_cast<float*>(smem) + 8 * PW_WORDS;
    float* stat = red + 8 * DM;
    bool presel = false;
    for (int s = blockIdx.x; s < TSAMP; s += gridDim.x) {
        const int t0 = blockIdx.x * 8 + w;
        const bool first = (s == (int)blockIdx.x) && (t0 < TPROMPT);
        if (first) peer_stage_scores(p, t0, wl);
        peer_token_block(p, l, TPROMPT + s, wl, red, stat, [&](int k) { if (first) peer_select_slice(p, l, wl, wl, k); });
        presel = presel || first;
    }
    const int tstride = gridDim.x * 8;
    int t = blockIdx.x * 8 + w;
    if (t < TPROMPT) {
        if (!presel) {
            peer_stage_scores(p, t, wl);
#pragma unroll 1
            for (int h = 0; h < 8; ++h) peer_select_slice(p, l, wl, wl, h);
        }
        int cur = 0;
#pragma unroll 1
        for (; t < TPROMPT; t += tstride) {
            const int tn = t + tstride;
            const bool has_next = tn < TPROMPT;
            float* slc = wl + cur * PW_SLOT; float* sln = wl + (cur ^ 1) * PW_SLOT;
            peer_token_gather(p, l, t, has_next ? tn : -1, wl, slc, [&](int k) { if (has_next) peer_select_slice(p, l, wl, sln, k); });
            cur ^= 1;
        }
    }
}

enum { PH_PRO = 0, PH_GEMM1, PH_MIXA, PH_SCAN, PH_MIXB, PH_GEMM2, PH_GEMM3, PH_PEER };

template <int PH>
__device__ __forceinline__ void run_phase(const Params& p, int l) {
    if (PH == PH_PRO) ph_prologue(p);
    else if (PH == PH_GEMM1) {
        gemm_phase<EPI_PROJ>(p.Xbf, p.wt_in + (long)l * NINP * DM, TPROMPT, NINP, DM, p.PROJ, nullptr, nullptr, 0.f,
                             ProjEpi{p.rope_cos, p.rope_sin, p.lb_logits, p.gla_wa2, p.gla_ba, p.out, l, nullptr, nullptr, nullptr, nullptr, nullptr, nullptr});
        if (l < 3) {
            const int ntile = (TPROMPT / BM) * (NINP / BM), fl = ntile % (int)gridDim.x, nb = (int)gridDim.x - fl;
            transpose_conv(p.w_in, DM, NIN, NINP, p.wt_in, l + 1, 1, fl, nb);
            transpose_conv(p.w_out, DM, DM, DM, p.wt_out, l + 1, 1, fl, nb);
            transpose_conv(p.peer_wq, DM, DM, DM, p.wt_q, l + 1, 1, fl, nb, p.ln1_g, p.ln1_b, p.CP1, p.CP2);
        }
    }
    else if (PH == PH_MIXA) ph_mix_a(p, l);
    else if (PH == PH_SCAN) ph_scan(p, l);
    else if (PH == PH_MIXB) ph_mix_b(p, l);
    else if (PH == PH_GEMM2) gemm_phase<EPI_RESID>(p.OCAT, p.wt_out + (long)l * DM * DM, TPROMPT, DM, DM, p.X1bf, nullptr, p.Xbf, ALPHA_F,
                                                       ProjEpi{nullptr, nullptr, nullptr, nullptr, nullptr, nullptr, l, nullptr, p.ZS + (long)l * TPROMPT * 16, nullptr, nullptr, nullptr, nullptr});
    else if (PH == PH_GEMM3) gemm_phase<EPI_SCORES>(p.X1bf, p.wt_q + (long)l * DM * DM, TPROMPT, DM, DM, p.Q, p.SC, nullptr, 0.f,
                                                        ProjEpi{nullptr, nullptr, nullptr, nullptr, nullptr, nullptr, l, p.keys + (long)l * 16 * 128 * 128,
                                                                p.ZS + (long)l * TPROMPT * 16, p.C1 + l * DM, p.C2 + l * DM, p.X1bf, reinterpret_cast<bf16_t*>(p.SC)});
    else if (PH == PH_PEER) ph_peer(p, l);
}

#if MK_ONE_LAUNCH
__global__ void __launch_bounds__(512, 2) k_mega(Params p) {
    extern __shared__ __attribute__((aligned(16))) char smem[];
    uint4* xbw = reinterpret_cast<uint4*>(smem + LDS_MAIN);
    if (threadIdx.x == 0) *xbw = make_uint4(0u, 0u, 0u, 0u);
    __syncthreads();
    XcdBarrier bar = xcd_barrier_post(p.bar, (volatile LAS unsigned*)xbw);
    for (int rep = 0; rep < REP_PRO; ++rep) { run_phase<PH_PRO>(p, 0); xcd_barrier(bar); }
    for (int l = 0; l < 4; ++l) {
        for (int rep = 0; rep < REP_G1; ++rep) { run_phase<PH_GEMM1>(p, l); xcd_barrier(bar); }
        for (int rep = 0; rep < REP_MIXA; ++rep) { run_phase<PH_MIXA>(p, l); xcd_barrier(bar); }
        run_phase<PH_SCAN>(p, l); xcd_barrier(bar);
        for (int rep = 0; rep < REP_MIXB; ++rep) { run_phase<PH_MIXB>(p, l); xcd_barrier(bar); }
        for (int rep = 0; rep < REP_G2; ++rep) { run_phase<PH_GEMM2>(p, l); xcd_barrier(bar); }
        for (int rep = 0; rep < REP_G3; ++rep) { run_phase<PH_GEMM3>(p, l); xcd_barrier(bar); }
        for (int rep = 0; rep < REP_PEER; ++rep) { run_phase<PH_PEER>(p, l); xcd_barrier(bar); }
    }
}
#endif

#if !MK_ONE_LAUNCH
template <int PH>
__global__ void __launch_bounds__(512, 2) k_phase(Params p, int l) { run_phase<PH>(p, l); }
template <int PH>
static void launch_phase(const Params& p, int l, int grid, hipStream_t stream) {
    static bool attr_set = false;
    if (!attr_set) { (void)hipFuncSetAttribute((const void*)k_phase<PH>, hipFuncAttributeMaxDynamicSharedMemorySize, LDS_BYTES); attr_set = true; }
    hipLaunchKernelGGL(k_phase<PH>, dim3(grid), dim3(NTHREADS), LDS_BYTES, stream, p, l);
}
#endif

extern "C" void kernel_launch(void* const* d_in, const int* in_sizes, int n_in,
                              void* d_out, int out_size, void* d_ws, size_t ws_size,
                              hipStream_t stream) {
    Params p{};
    p.x_prompt = (const float*)d_in[0]; p.x_sample = (const float*)d_in[1]; p.cache_k = (const float*)d_in[2]; p.cache_v = (const float*)d_in[3];
    p.state_hgrn = (const float*)d_in[4]; p.state_gla = (const float*)d_in[5]; p.w_in = (const float*)d_in[6]; p.w_out = (const float*)d_in[7];
    p.sinks = (const float*)d_in[8]; p.hgrn_nw = (const float*)d_in[9]; p.lb_logits = (const float*)d_in[10]; p.gla_wa2 = (const float*)d_in[11];
    p.gla_ba = (const float*)d_in[12]; p.gla_nw = (const float*)d_in[13]; p.ln1_g = (const float*)d_in[14]; p.ln1_b = (const float*)d_in[15];
    p.ln2_g = (const float*)d_in[16]; p.ln2_b = (const float*)d_in[17]; p.peer_wq = (const float*)d_in[18]; p.peer_keys = (const float*)d_in[19];
    p.peer_u = (const float*)d_in[20]; p.peer_v = (const float*)d_in[21];
    p.out = (float*)d_out;
    char* ws = (char*)d_ws;
    size_t off = 0;
    auto take = [&](size_t bytes) { char* r = ws + off; off += (bytes + 255) & ~(size_t)255; return r; };
    p.bar = (unsigned*)take(XCD_BAR_WORDS * 4);
    const size_t zero_bytes = off;
    p.ZS = (float*)take(4UL * TPROMPT * 16 * 4);
    p.C1 = (float*)take(4UL * DM * 4);
    p.C2 = (float*)take(4UL * DM * 4);
    p.CP1 = (float*)take(4UL * 32 * DM * 4);
    p.CP2 = (float*)take(4UL * 32 * DM * 4);
    p.wt_in = (bf16_t*)take(4UL * NINP * DM * 2);
    p.wt_out = (bf16_t*)take(4UL * DM * DM * 2);
    p.wt_q = (bf16_t*)take(4UL * DM * DM * 2);
    p.keys = (bf16_t*)take(4UL * 16 * 128 * 128 * 2);
    p.U8 = (unsigned char*)take(4UL * NEXP * 2048);
    p.V8 = (unsigned char*)take(4UL * NEXP * 2048);
    p.Usc = (float*)take(4UL * NEXP * 4);
    p.Vsc = (float*)take(4UL * NEXP * 4);
    p.rope_cos = (float*)take(2049UL * 32 * 4);
    p.rope_sin = (float*)take(2049UL * 32 * 4);
    p.Xf = (float*)take((size_t)TPAD * DM * 4);
    p.Xbf = (bf16_t*)take((size_t)TPAD * DM * 2);
    p.PROJ = (bf16_t*)take((size_t)TPAD * NINP * 2);
    p.OCAT = (bf16_t*)take((size_t)TPAD * DM * 2);
    p.Z1 = (float*)take((size_t)TPAD * DM * 4);
    p.X1f = (float*)take((size_t)TPAD * DM * 4);
    p.X1bf = (bf16_t*)take((size_t)TPAD * DM * 2);
    p.Q = (bf16_t*)take((size_t)TPAD * DM * 2);
    p.SC = (float*)take((size_t)TPAD * DM * 4);
    p.HST = (bf16_t*)take(16UL * 33 * 128 * 128 * 2);
    p.GST = (bf16_t*)take(16UL * 33 * 64 * 128 * 2);
    p.HD = (float*)take(16UL * 32 * 128 * 4);
    p.GD = (float*)take(16UL * 32 * 64 * 4);
    p.LFC = (bf16_t*)take((size_t)TPROMPT * 256 * 2);

    static int grid = 0;
    if (!grid) {
        int dev = 0, cus = 0;
        (void)hipGetDevice(&dev);
        (void)hipDeviceGetAttribute(&cus, hipDeviceAttributeMultiprocessorCount, dev);
        grid = cus > 0 ? cus : 256;
    }
#if MK_ONE_LAUNCH
    static bool attr_set = false;
    if (!attr_set) {
        (void)hipFuncSetAttribute((const void*)k_mega, hipFuncAttributeMaxDynamicSharedMemorySize, LDS_BYTES);
        int per_cu = 0;
        (void)hipOccupancyMaxActiveBlocksPerMultiprocessor(&per_cu, (const void*)k_mega, NTHREADS, LDS_BYTES);
        if (per_cu < 1) grid = 0;
        attr_set = true;
    }
    if (grid <= 0) return;
    (void)hipMemsetAsync(d_ws, 0, zero_bytes, stream);
    hipLaunchKernelGGL(k_mega, dim3(grid), dim3(NTHREADS), LDS_BYTES, stream, p);
#else
    (void)hipMemsetAsync(d_ws, 0, zero_bytes, stream);
    launch_phase<PH_PRO>(p, 0, grid, stream);
    for (int l = 0; l < 4; ++l) {
        launch_phase<PH_GEMM1>(p, l, grid, stream);
        launch_phase<PH_MIXA>(p, l, grid, stream);
        launch_phase<PH_SCAN>(p, l, grid, stream);
        launch_phase<PH_MIXB>(p, l, grid, stream);
        launch_phase<PH_GEMM2>(p, l, grid, stream);
        launch_phase<PH_GEMM3>(p, l, grid, stream);
        launch_phase<PH_PEER>(p, l, grid, stream);
    }
#endif
}
```

```cpp
#include <hip/hip_runtime.h>
#include <stdint.h>

#ifndef MK_ONE_LAUNCH
#define MK_ONE_LAUNCH 1
#endif
#ifndef PEER_U_FMT
#define PEER_U_FMT 5
#endif
#ifndef PEER_V_FMT
#define PEER_V_FMT 5
#endif
#ifndef PEER_MFMA_U
#define PEER_MFMA_U 1
#endif
#ifndef PEER_F16
#define PEER_F16 1
#endif
#define REP_PRO 1
#define REP_G1 1
#define REP_G2 1
#define REP_G3 1
#define REP_MIXA 1
#define REP_MIXB 1
#define REP_PEER 1


typedef unsigned short bf16_t;
using bf16x8 = __attribute__((ext_vector_type(8))) short;
using f32x4 = __attribute__((ext_vector_type(4))) float;

constexpr int DM = 2048;
constexpr int SEQ = 2048;
constexpr int NBATCH = 4;
constexpr int TPROMPT = 8192;
constexpr int TSAMP = 32;
constexpr int TTOK = 8224;
constexpr int TPAD = 8448;
constexpr int NIN = 4880;
constexpr int NINP = 5120;
constexpr int NEXP = 16384;
constexpr int NTHREADS = 512;
constexpr float ALPHA_F = 1.681792830507429f;

constexpr int C_QA = 0, C_KA = 1024, C_VA = 1152, C_QB = 1280, C_FB = 1792, C_IB = 2304, C_GB = 2816;
constexpr int C_QC = 3328, C_KC = 3584, C_VC = 3840, C_GC = 4352, C_AC = 4864;

constexpr long O_YP = 0;
constexpr long O_YS = O_YP + 16777216L;
constexpr long O_KP = O_YS + 65536L;
constexpr long O_VP = O_KP + 262144L;
constexpr long O_HP = O_VP + 262144L;
constexpr long O_GP = O_HP + 1048576L;
constexpr long O_KS = O_GP + 524288L;
constexpr long O_VS = O_KS + 2097152L;
constexpr long O_HS = O_VS + 2097152L;
constexpr long O_GS = O_HS + 8388608L;

constexpr int LDS_MAIN = 163776 - 0;
constexpr int LDS_BYTES = LDS_MAIN + 64;

struct Params {
    const float *x_prompt, *x_sample, *cache_k, *cache_v, *state_hgrn, *state_gla, *w_in, *w_out, *sinks, *hgrn_nw,
        *lb_logits, *gla_wa2, *gla_ba, *gla_nw, *ln1_g, *ln1_b, *ln2_g, *ln2_b, *peer_wq, *peer_keys, *peer_u, *peer_v;
    float* out;
    unsigned* bar;
    bf16_t *wt_in, *wt_out, *wt_q, *keys;
    unsigned char *U8, *V8;
    float *Usc, *Vsc;
    float *rope_cos, *rope_sin;
    float* Xf; bf16_t* Xbf; bf16_t* PROJ; bf16_t* OCAT; float* Z1; float* X1f; bf16_t* X1bf; bf16_t* Q; float* SC;
    bf16_t *HST, *GST;
    float *HD, *GD;
    bf16_t* LFC;
    float* ZS;
    float *C1, *C2;
    float *CP1, *CP2;
};

__device__ __forceinline__ float bf2f(bf16_t h) { return __uint_as_float(((unsigned)h) << 16); }
__device__ __forceinline__ bf16_t f2bf(float f) { __bf16 b = (__bf16)f; return __builtin_bit_cast(unsigned short, b); }
__device__ __forceinline__ unsigned pack2(float a, float b) { return (unsigned)f2bf(a) | ((unsigned)f2bf(b) << 16); }
__device__ __forceinline__ void unpack8(const uint4 v, float* f) {
    f[0] = __uint_as_float(v.x << 16); f[1] = __uint_as_float(v.x & 0xffff0000u);
    f[2] = __uint_as_float(v.y << 16); f[3] = __uint_as_float(v.y & 0xffff0000u);
    f[4] = __uint_as_float(v.z << 16); f[5] = __uint_as_float(v.z & 0xffff0000u);
    f[6] = __uint_as_float(v.w << 16); f[7] = __uint_as_float(v.w & 0xffff0000u);
}
__device__ __forceinline__ uint4 pack8(const float* f) {
    uint4 v; v.x = pack2(f[0], f[1]); v.y = pack2(f[2], f[3]); v.z = pack2(f[4], f[5]); v.w = pack2(f[6], f[7]); return v;
}

__device__ __forceinline__ void wave_lds_fence() {
    __builtin_amdgcn_fence(__ATOMIC_RELEASE, "wavefront");
    __builtin_amdgcn_wave_barrier();
    __builtin_amdgcn_fence(__ATOMIC_ACQUIRE, "wavefront");
}
template <int CTRL> __device__ __forceinline__ float dpp_mov(float v) {
    return __int_as_float(__builtin_amdgcn_update_dpp(__float_as_int(v), __float_as_int(v), CTRL, 0xf, 0xf, false));
}
__device__ __forceinline__ float row16_max(float v) {
    v = fmaxf(v, dpp_mov<0xB1>(v)); v = fmaxf(v, dpp_mov<0x4E>(v)); v = fmaxf(v, dpp_mov<0x141>(v)); v = fmaxf(v, dpp_mov<0x140>(v));
    return v;
}
__device__ __forceinline__ float row16_sum(float v) {
    v = v + dpp_mov<0xB1>(v); v = v + dpp_mov<0x4E>(v); v = v + dpp_mov<0x141>(v); v = v + dpp_mov<0x140>(v);
    return v;
}
__device__ __forceinline__ float rdlane(float v, int l) { return __int_as_float(__builtin_amdgcn_readlane(__float_as_int(v), l)); }
__device__ __forceinline__ float wave_max(float v) {
    v = row16_max(v);
    return fmaxf(fmaxf(rdlane(v, 0), rdlane(v, 16)), fmaxf(rdlane(v, 32), rdlane(v, 48)));
}
__device__ __forceinline__ float wave_sum(float v) {
    v = row16_sum(v);
    return (rdlane(v, 0) + rdlane(v, 16)) + (rdlane(v, 32) + rdlane(v, 48));
}
template <int CTRL> __device__ __forceinline__ unsigned dpp_mov_u(unsigned v) {
    return (unsigned)__builtin_amdgcn_update_dpp((int)v, (int)v, CTRL, 0xf, 0xf, false);
}
__device__ __forceinline__ unsigned umax_(unsigned a, unsigned b) { return a > b ? a : b; }
__device__ __forceinline__ unsigned wave_max_u32(unsigned v) {
    v = umax_(v, dpp_mov_u<0xB1>(v)); v = umax_(v, dpp_mov_u<0x4E>(v)); v = umax_(v, dpp_mov_u<0x141>(v)); v = umax_(v, dpp_mov_u<0x140>(v));
    const unsigned a = (unsigned)__builtin_amdgcn_readlane((int)v, 0), b = (unsigned)__builtin_amdgcn_readlane((int)v, 16);
    const unsigned c = (unsigned)__builtin_amdgcn_readlane((int)v, 32), d = (unsigned)__builtin_amdgcn_readlane((int)v, 48);
    return umax_(umax_(a, b), umax_(c, d));
}
__device__ __forceinline__ f32x4 mfma16(bf16x8 a, bf16x8 b, f32x4 c) { return __builtin_amdgcn_mfma_f32_16x16x32_bf16(a, b, c, 0, 0, 0); }
__device__ __forceinline__ bf16x8 ldfrag(const bf16_t* base, int stride, int row0, int k0, int lane) {
    return *reinterpret_cast<const bf16x8*>(base + (row0 + (lane & 15)) * stride + k0 + (lane >> 4) * 8);
}
__device__ __forceinline__ float sigmoidf_(float x) { return __builtin_amdgcn_rcpf(1.f + __expf(-x)); }
__device__ __forceinline__ float siluf_(float x) { return x * __builtin_amdgcn_rcpf(1.f + __expf(-x)); }
__device__ __forceinline__ float logsigmoidf_(float x) { return fminf(x, 0.f) - __logf(1.f + __expf(-fabsf(x))); }
__device__ __forceinline__ float geluf_(float x) { return 0.5f * x * (1.f + erff(x * 0.7071067811865476f)); }

__device__ __forceinline__ float hgrn_lower(const float* lb, int l, int col) {
    if (l == 0) return 0.f;
    float a0 = lb[col], a1 = lb[512 + col], a2 = lb[1024 + col], a3 = lb[1536 + col];
    float mx = fmaxf(fmaxf(a0, a1), fmaxf(a2, a3));
    float e0 = __expf(a0 - mx), e1 = __expf(a1 - mx), e2 = __expf(a2 - mx), e3 = __expf(a3 - mx);
    float inv = 1.f / (e0 + e1 + e2 + e3);
    float s = e1; if (l >= 2) s += e2; if (l >= 3) s += e3;
    return s * inv;
}

__device__ __forceinline__ int otid() { int t = threadIdx.x; asm volatile("" : "+v"(t)); return t; }

#define XB_TMO      128
#define XB_XCNT(j)  (256  + 64 * (j))
#define XB_XSUB(j)  (1280 + 64 * (j))
#define XB_XGEN(j)  (2304 + 64 * (j))
#define XB_TOP      3328
#define XB_TOPGEN   3392
#define XCD_BAR_WORDS 3456
#define XB_SPIN_CAP (1u << 22)
#define LAS __attribute__((address_space(3)))

__device__ __forceinline__ unsigned xb_ld(unsigned* p)              { return __hip_atomic_load(p, __ATOMIC_RELAXED, __HIP_MEMORY_SCOPE_AGENT); }
__device__ __forceinline__ unsigned xb_add(unsigned* p, unsigned v) { return __hip_atomic_fetch_add(p, v, __ATOMIC_RELAXED, __HIP_MEMORY_SCOPE_AGENT); }
__device__ __forceinline__ unsigned xb_xcc_id() { return (unsigned)__builtin_amdgcn_s_getreg((3 << 11) | 20) & 0xFu; }
#define XB_SPIN(cond, bar) do { unsigned _sp = 0; while (cond) { __builtin_amdgcn_s_sleep(1); \
    if ((++_sp & 255u) == 0u) { if (xb_ld(&(bar)[XB_TMO])) break; if (_sp > XB_SPIN_CAP) { atomicAdd(&(bar)[XB_TMO], 1u); break; } } } } while (0)

struct XcdBarrier {
    unsigned* bar; unsigned x;
    volatile LAS unsigned* st;
};
__device__ __forceinline__ XcdBarrier xcd_barrier_post(unsigned* bar, volatile LAS unsigned* st) {
    XcdBarrier b; b.bar = bar; b.x = xb_xcc_id(); b.st = st;
    if (threadIdx.x == 0) (void)xb_add(&bar[XB_XCNT(b.x)], 1u);
    return b;
}
__device__ __forceinline__ void xcd_barrier_complete(unsigned* bar, unsigned x, unsigned& nloc, unsigned& nx) {
    const unsigned G = gridDim.x * gridDim.y * gridDim.z;
    unsigned sum, cnt, mine, sp = 0u;
    for (;;) {
        sum = 0u; cnt = 0u; mine = 0u;
#pragma unroll
        for (unsigned j = 0; j < 16; ++j) { const unsigned c = xb_ld(&bar[XB_XCNT(j)]); sum += c; cnt += (c > 0u) ? 1u : 0u; mine = (j == x) ? c : mine; }
        if (sum == G) break;
        __builtin_amdgcn_s_sleep(1);
        if ((++sp & 255u) == 0u) { if (xb_ld(&bar[XB_TMO])) break; if (sp > XB_SPIN_CAP) { atomicAdd(&bar[XB_TMO], 1u); break; } }
    }
    nloc = mine > 0u ? mine : 1u; nx = cnt > 0u ? cnt : 1u;
}
__device__ __forceinline__ void xcd_barrier(const XcdBarrier& b) {
    asm volatile("s_waitcnt vmcnt(0)" ::: "memory");
    __syncthreads();
    if (threadIdx.x == 0) {
        unsigned* bar = b.bar;
        __builtin_amdgcn_s_waitcnt(0);
        const unsigned bx = xb_xcc_id();
        unsigned nloc = b.st[0], nx = b.st[1];
        if (nloc == 0u) { xcd_barrier_complete(bar, bx, nloc, nx); b.st[0] = nloc; b.st[1] = nx; }
        const unsigned old = xb_add(&bar[XB_XSUB(bx)], 1u);
        const unsigned gen = old / nloc;
        if (old + 1u == (gen + 1u) * nloc) {
            __builtin_amdgcn_fence(__ATOMIC_RELEASE, "agent");
            asm volatile("s_waitcnt vmcnt(0)" ::: "memory");
            const unsigned og = xb_add(&bar[XB_TOP], 1u);
            const unsigned tg = og / nx;
            if (og + 1u == (tg + 1u) * nx) xb_add(&bar[XB_TOPGEN], 1u);
            else XB_SPIN(xb_ld(&bar[XB_TOPGEN]) == tg, bar);
            __builtin_amdgcn_fence(__ATOMIC_ACQUIRE, "agent");
            xb_add(&bar[XB_XGEN(bx)], 1u);
            asm volatile("s_waitcnt vmcnt(0)" ::: "memory");
        } else {
            XB_SPIN(xb_ld(&bar[XB_XGEN(bx)]) == gen, bar);
            __builtin_amdgcn_fence(__ATOMIC_ACQUIRE, "agent");
            asm volatile("s_waitcnt vmcnt(0)" ::: "memory");
        }
    }
    __syncthreads();
}

__device__ __forceinline__ void conv_elem(const float* __restrict__ src, bf16_t* __restrict__ dst, long n, long gtid, long gsz) {
    for (long i = gtid * 8; i < n; i += gsz * 8) {
        float4 a = *reinterpret_cast<const float4*>(src + i);
        float4 b = *reinterpret_cast<const float4*>(src + i + 4);
        uint4 v; v.x = pack2(a.x, a.y); v.y = pack2(a.z, a.w); v.z = pack2(b.x, b.y); v.w = pack2(b.z, b.w);
        *reinterpret_cast<uint4*>(dst + i) = v;
    }
}
__device__ __forceinline__ void conv_rows_fp8(const float* __restrict__ src, unsigned char* __restrict__ dst, float* __restrict__ scl, int nrows) {
    const int tid = otid(), lane = tid & 63;
    const int gw = blockIdx.x * 8 + (tid >> 6), nw = gridDim.x * 8;
    for (int r = gw * 2; r < nrows; r += nw * 2) {
        float v[2][32];
#pragma unroll
        for (int rr = 0; rr < 2; ++rr)
#pragma unroll
            for (int i = 0; i < 2; ++i)
#pragma unroll
                for (int q = 0; q < 4; ++q) {
                    const float4 a = *reinterpret_cast<const float4*>(src + (long)(r + rr) * DM + i * 1024 + lane * 16 + q * 4);
                    v[rr][i * 16 + q * 4] = a.x; v[rr][i * 16 + q * 4 + 1] = a.y; v[rr][i * 16 + q * 4 + 2] = a.z; v[rr][i * 16 + q * 4 + 3] = a.w;
                }
#pragma unroll
        for (int rr = 0; rr < 2; ++rr) {
            float am = 0.f;
#pragma unroll
            for (int i = 0; i < 32; ++i) am = fmaxf(am, fabsf(v[rr][i]));
            am = wave_max(am);
            const float sc = am > 0.f ? 448.f / am : 1.f;
            if (lane == 0) scl[r + rr] = am > 0.f ? am * (1.f / 448.f) : 1.f;
#pragma unroll
            for (int i = 0; i < 2; ++i) {
                unsigned o[4];
#pragma unroll
                for (int q = 0; q < 4; ++q) {
                    int pk = __builtin_amdgcn_cvt_pk_fp8_f32(v[rr][i * 16 + q * 4] * sc, v[rr][i * 16 + q * 4 + 1] * sc, 0, false);
                    pk = __builtin_amdgcn_cvt_pk_fp8_f32(v[rr][i * 16 + q * 4 + 2] * sc, v[rr][i * 16 + q * 4 + 3] * sc, pk, true);
                    o[q] = (unsigned)pk;
                }
                *reinterpret_cast<uint4*>(dst + (long)(r + rr) * DM + i * 1024 + lane * 16) = make_uint4(o[0], o[1], o[2], o[3]);
            }
        }
    }
}
__device__ __forceinline__ void conv_rows_fp4(const float* __restrict__ src, unsigned char* __restrict__ dst, int nrows) {
    const int tid = otid(), lane = tid & 63;
    const int gw = blockIdx.x * 8 + (tid >> 6), nw = gridDim.x * 8;
    for (int r = gw * 2; r < nrows; r += nw * 2) {
        float v[2][32];
#pragma unroll
        for (int rr = 0; rr < 2; ++rr)
#pragma unroll
            for (int q = 0; q < 8; ++q) {
                const float4 a = *reinterpret_cast<const float4*>(src + (long)(r + rr) * DM + lane * 32 + q * 4);
                v[rr][q * 4] = a.x; v[rr][q * 4 + 1] = a.y; v[rr][q * 4 + 2] = a.z; v[rr][q * 4 + 3] = a.w;
            }
#pragma unroll
        for (int rr = 0; rr < 2; ++rr) {
            float am = 0.f;
#pragma unroll
            for (int i = 0; i < 32; ++i) am = fmaxf(am, fabsf(v[rr][i]));
            int e = 0;
            if (am > 0.f) { const float m = frexpf(am * (1.f / 6.f), &e); if (m == 0.5f) e -= 1; }
            e = e < -126 ? -126 : (e > 126 ? 126 : e);
            const float inv = __uint_as_float((unsigned)(127 - e) << 23);
            unsigned o[4];
#pragma unroll
            for (int w = 0; w < 4; ++w) {
                unsigned pk = 0u;
                pk = __builtin_amdgcn_cvt_scalef32_pk_fp4_f32(pk, v[rr][w * 8 + 0] * inv, v[rr][w * 8 + 1] * inv, 1.0f, 0);
                pk = __builtin_amdgcn_cvt_scalef32_pk_fp4_f32(pk, v[rr][w * 8 + 2] * inv, v[rr][w * 8 + 3] * inv, 1.0f, 1);
                pk = __builtin_amdgcn_cvt_scalef32_pk_fp4_f32(pk, v[rr][w * 8 + 4] * inv, v[rr][w * 8 + 5] * inv, 1.0f, 2);
                pk = __builtin_amdgcn_cvt_scalef32_pk_fp4_f32(pk, v[rr][w * 8 + 6] * inv, v[rr][w * 8 + 7] * inv, 1.0f, 3);
                o[w] = pk;
            }
            unsigned char* drow = dst + (long)(r + rr) * 1088;
            *reinterpret_cast<uint4*>(drow + lane * 16) = make_uint4(o[0], o[1], o[2], o[3]);
            drow[1024 + lane] = (unsigned char)(e + 127);
        }
    }
}
__device__ __forceinline__ void conv_rows_fp4r(const float* __restrict__ src, unsigned char* __restrict__ dst, float* __restrict__ scl, int nrows) {
    const int tid = otid(), lane = tid & 63;
    const int gw = blockIdx.x * 8 + (tid >> 6), nw = gridDim.x * 8;
    typedef float f4 __attribute__((ext_vector_type(4)));
    f4 cur[2][8], nxt[2][8];
    auto issue = [&](f4 (&buf)[2][8], int r) {
#pragma unroll
        for (int rr = 0; rr < 2; ++rr)
#pragma unroll
            for (int q = 0; q < 8; ++q)
                buf[rr][q] = *reinterpret_cast<const f4*>(src + (long)(r + rr) * DM + lane * 32 + q * 4);
    };
    int r = gw * 2;
    if (r < nrows) issue(cur, r);
    for (; r < nrows; r += nw * 2) {
        const int rn = r + nw * 2;
        if (rn < nrows) issue(nxt, rn);
#pragma unroll
        for (int rr = 0; rr < 2; ++rr) {
            float am = 0.f;
#pragma unroll
            for (int q = 0; q < 8; ++q) am = fmaxf(am, fmaxf(fmaxf(fabsf(cur[rr][q].x), fabsf(cur[rr][q].y)), fmaxf(fabsf(cur[rr][q].z), fabsf(cur[rr][q].w))));
            am = wave_max(am);
            const float sc = am > 0.f ? 6.f / am : 1.f;
            if (lane == 0) scl[r + rr] = am > 0.f ? am * (1.f / 6.f) : 1.f;
            unsigned o[4];
#pragma unroll
            for (int w = 0; w < 4; ++w) {
                unsigned pk = 0u;
                pk = __builtin_amdgcn_cvt_scalef32_pk_fp4_f32(pk, cur[rr][2 * w].x * sc, cur[rr][2 * w].y * sc, 1.0f, 0);
                pk = __builtin_amdgcn_cvt_scalef32_pk_fp4_f32(pk, cur[rr][2 * w].z * sc, cur[rr][2 * w].w * sc, 1.0f, 1);
                pk = __builtin_amdgcn_cvt_scalef32_pk_fp4_f32(pk, cur[rr][2 * w + 1].x * sc, cur[rr][2 * w + 1].y * sc, 1.0f, 2);
                pk = __builtin_amdgcn_cvt_scalef32_pk_fp4_f32(pk, cur[rr][2 * w + 1].z * sc, cur[rr][2 * w + 1].w * sc, 1.0f, 3);
                o[w] = pk;
            }
            *reinterpret_cast<uint4*>(dst + (long)(r + rr) * 1024 + lane * 16) = make_uint4(o[0], o[1], o[2], o[3]);
        }
#pragma unroll
        for (int rr = 0; rr < 2; ++rr)
#pragma unroll
            for (int q = 0; q < 8; ++q) cur[rr][q] = nxt[rr][q];
    }
}
__device__ __forceinline__ void transpose_conv(const float* __restrict__ W, int K, int N, int NP, bf16_t* __restrict__ Wt, int layer0, int nlayers,
                                               int bfirst, int nblk,
                                               const float* __restrict__ gain = nullptr, const float* __restrict__ bias = nullptr,
                                               float* __restrict__ c1 = nullptr, float* __restrict__ c2 = nullptr) {
    extern __shared__ __attribute__((aligned(16))) char smem[];
    float* tile = reinterpret_cast<float*>(smem);
    const int tid = otid();
    const int nkt = K / 64, nnt = NP / 256, items = nlayers * nkt * nnt;
    if ((int)blockIdx.x < bfirst || (int)blockIdx.x >= bfirst + nblk) return;
    for (int it = (int)blockIdx.x - bfirst; it < items; it += nblk) {
        const int l = layer0 + it / (nkt * nnt), r = it % (nkt * nnt), kt = r / nnt, nt = r % nnt;
        const float* Wl = W + (long)l * K * N;
        bf16_t* Wtl = Wt + (long)l * NP * K;
        {
            const int kk = tid >> 3, c0 = (tid & 7) * 4;
            float4 v[8];
#pragma unroll
            for (int i = 0; i < 8; ++i) {
                const int n = nt * 256 + c0 + i * 32;
                v[i] = (n < N) ? *reinterpret_cast<const float4*>(Wl + (long)(kt * 64 + kk) * N + n) : make_float4(0.f, 0.f, 0.f, 0.f);
            }
            float gk = 1.f, bk = 0.f;
            if (gain != nullptr) { gk = gain[l * K + kt * 64 + kk]; bk = bias[l * K + kt * 64 + kk]; }
#pragma unroll
            for (int i = 0; i < 8; ++i) {
                float* tp = tile + kk * 257 + c0 + i * 32;
                tp[0] = v[i].x; tp[1] = v[i].y; tp[2] = v[i].z; tp[3] = v[i].w;
            }
            (void)gk; (void)bk;
        }
        __syncthreads();
        {
            const int nn = tid & 255, kh = tid >> 8;
            float vals[32];
#pragma unroll
            for (int i = 0; i < 32; ++i) vals[i] = tile[(kh * 32 + i) * 257 + nn];
            float s1 = 0.f, s2 = 0.f;
            if (gain != nullptr) {
#pragma unroll
                for (int i = 0; i < 32; ++i) {
                    const float raw = vals[i];
                    vals[i] = bf2f(f2bf(raw * gain[l * K + kt * 64 + kh * 32 + i]));
                    s1 += vals[i]; s2 += raw * bias[l * K + kt * 64 + kh * 32 + i];
                }
            }
            bf16_t* dst = Wtl + (long)(nt * 256 + nn) * K + kt * 64 + kh * 32;
#pragma unroll
            for (int i = 0; i < 4; ++i) *reinterpret_cast<uint4*>(dst + i * 8) = pack8(vals + i * 8);
            if (gain != nullptr) {
                __syncthreads();
                float* ps = tile;
                ps[(kh * 256 + nn) * 2] = s1; ps[(kh * 256 + nn) * 2 + 1] = s2;
                __syncthreads();
                if (tid < 256) {
                    c1[((long)l * nkt + kt) * NP + nt * 256 + tid] = ps[tid * 2] + ps[(256 + tid) * 2];
                    c2[((long)l * nkt + kt) * NP + nt * 256 + tid] = ps[tid * 2 + 1] + ps[(256 + tid) * 2 + 1];
                }
            }
        }
        __syncthreads();
    }
}
__device__ __forceinline__ void ph_prologue(const Params& p) {
    const int tid = otid();
    const long gtid = (long)blockIdx.x * 512 + tid, gsz = (long)gridDim.x * 512;
    if (PEER_U_FMT == 8) conv_rows_fp8(p.peer_u, p.U8, p.Usc, 4 * NEXP); else if (PEER_U_FMT == 5) conv_rows_fp4r(p.peer_u, p.U8, p.Usc, 4 * NEXP); else conv_rows_fp4(p.peer_u, p.U8, 4 * NEXP);
    if (PEER_V_FMT == 8) conv_rows_fp8(p.peer_v, p.V8, p.Vsc, 4 * NEXP); else if (PEER_V_FMT == 5) conv_rows_fp4r(p.peer_v, p.V8, p.Vsc, 4 * NEXP); else conv_rows_fp4(p.peer_v, p.V8, 4 * NEXP);
    conv_elem(p.peer_keys, p.keys, 4L * 16 * 128 * 128, gtid, gsz);
    transpose_conv(p.w_in, DM, NIN, NINP, p.wt_in, 0, 1, 0, gridDim.x);
    transpose_conv(p.w_out, DM, DM, DM, p.wt_out, 0, 1, 0, gridDim.x);
    transpose_conv(p.peer_wq, DM, DM, DM, p.wt_q, 0, 1, 0, gridDim.x, p.ln1_g, p.ln1_b, p.CP1, p.CP2);
    for (long i = gtid; i < 2049L * 32; i += gsz) {
        const int pi = (int)(i >> 5), fi = (int)(i & 31);
        const double pos = (pi < 2048) ? (double)pi : 16384.0;
        const double inv = pow(10000.0, -(double)fi / 32.0);
        const double ang = pos * inv;
        p.rope_cos[i] = (float)cos(ang);
        p.rope_sin[i] = (float)sin(ang);
    }
    for (long i = gtid * 4; i < (long)TPAD * DM; i += gsz * 4) {
        const long row = i / DM; const int col = (int)(i % DM);
        float4 v = make_float4(0.f, 0.f, 0.f, 0.f);
        if (row < TPROMPT) v = *reinterpret_cast<const float4*>(p.x_prompt + row * DM + col);
        else if (row < TTOK) v = *reinterpret_cast<const float4*>(p.x_sample + (row - TPROMPT) * DM + col);
        uint2 b; b.x = pack2(v.x, v.y); b.y = pack2(v.z, v.w);
        *reinterpret_cast<uint2*>(p.Xbf + i) = b;
    }
    for (long i = gtid; i < (long)(TPAD - TTOK) * DM; i += gsz) {
        p.OCAT[(long)TTOK * DM + i] = 0;
        p.X1bf[(long)TTOK * DM + i] = 0;
    }
}

constexpr int BM = 256, BK = 64, HALF = 128, NXCD = 8, WGM = 8, HT = HALF * BK;

__device__ __forceinline__ int lds_byte(int r, int c) {
    int st = (r >> 4) * 2 + (c >> 5), rr = r & 15, cc = c & 31, ob = rr * 64 + cc * 2;
    return st * 1024 + (ob ^ (((ob >> 9) & 1) << 5));
}
__device__ __forceinline__ void stage_rc(int b, int& R, int& C) {
    int st = b / 1024, sb = b % 1024, swz = sb ^ (((sb >> 9) & 1) << 5);
    R = (st >> 1) * 16 + swz / 64; C = (st & 1) * 32 + (swz % 64) / 2;
}

enum { EPI_BF16 = 0, EPI_RESID = 1, EPI_PROJ = 2, EPI_SCORES = 3 };
struct ProjEpi { const float *rope_cos, *rope_sin, *lb, *wa2, *ba; float* out; int l; const bf16_t* keys; float* zs; const float *c1, *c2; const bf16_t* zb; bf16_t* scb; };


template <int EPI>
__device__ __forceinline__ void skinny_item(const bf16_t* __restrict__ A, const bf16_t* __restrict__ Bt, int N, int K, int n0,
                                            bf16_t* __restrict__ Cb, float* __restrict__ Cf, const bf16_t* __restrict__ R, float alpha, const ProjEpi pe);

template <int EPI>
__device__ __forceinline__ void gemm_phase(const bf16_t* __restrict__ A, const bf16_t* __restrict__ Bt, int M, int N, int K,
                           bf16_t* __restrict__ Cb, float* __restrict__ Cf, const bf16_t* __restrict__ R, float alpha, const ProjEpi pe) {
    extern __shared__ __attribute__((aligned(16))) char smem[];
    bf16_t* shm = reinterpret_cast<bf16_t*>(smem);
#define SA(b, h) (shm + ((b) * 2 + (h)) * HT)
#define SB(b, h) (shm + (4 + (b) * 2 + (h)) * HT)
#define STAGE_X(T, P, BASE, br, kt) do { long _g = (long)(br) * K + (long)(kt) * BK; \
    for (int _i = 0; _i < 2; ++_i) { int _b = (T) * 16 + _i * 8192; int _r, _c; stage_rc(_b, _r, _c); \
      __builtin_amdgcn_global_load_lds((const unsigned*)(BASE + _g + (long)_r * K + _c), \
        (unsigned*)((char*)(P) + _b), 16, 0, 0); } } while (0)
#define STAGE(P, BASE, br, kt) STAGE_X(tx, P, BASE, br, kt)
#define LDA(dst, b, h) for (int m = 0; m < 4; ++m) for (int k = 0; k < 2; ++k) \
    dst[m][k] = *reinterpret_cast<const bf16x8*>((char*)SA(b, h) + lds_byte(wr * 64 + m * 16 + fr, k * 32 + fq * 8))
#define LDB(dst, b, h) for (int n = 0; n < 2; ++n) for (int k = 0; k < 2; ++k) \
    dst[n][k] = *reinterpret_cast<const bf16x8*>((char*)SB(b, h) + lds_byte(wc * 32 + n * 16 + fr, k * 32 + fq * 8))
#define MMA(ai, bj, At_, Bt_) do { __builtin_amdgcn_s_setprio(1); \
    for (int m = 0; m < 4; ++m) for (int n = 0; n < 2; ++n) for (int k = 0; k < 2; ++k) \
      acc[ai][bj][m][n] = __builtin_amdgcn_mfma_f32_16x16x32_bf16(At_[m][k], Bt_[n][k], acc[ai][bj][m][n], 0, 0, 0); \
    __builtin_amdgcn_s_setprio(0); } while (0)
#define WAIT_V(n) asm volatile("s_waitcnt vmcnt(" #n ")" ::: "memory")
#define WAIT_L(n) asm volatile("s_waitcnt lgkmcnt(" #n ")" ::: "memory")
#define BAR __builtin_amdgcn_s_barrier()
#define SCHED __builtin_amdgcn_sched_barrier(0)

    const int nM = M / BM, nN = N / BM, nwg = nM * nN;
    const int nt = K / BK;
    for (int tile = blockIdx.x; tile < nwg; tile += gridDim.x) {
        int wgid = tile;
        { int q = nwg / NXCD, r = nwg % NXCD, xcd = wgid % NXCD, off = wgid / NXCD;
          wgid = (xcd < r ? xcd * (q + 1) : r * (q + 1) + (xcd - r) * q) + off; }
        int nig = WGM * nN, gid = wgid / nig, fm = gid * WGM, gsz = min(nM - fm, WGM);
        int pm = fm + ((wgid % nig) % gsz), pn = (wgid % nig) / gsz, brow = pm * BM, bcol = pn * BM;
        int tx = otid(); asm volatile("" : "+v"(tx)); int wid = tx >> 6, lane = tx & 63, wr = wid >> 2, wc = wid & 3, fr = lane & 15, fq = lane >> 4;
        f32x4 acc[2][2][4][2] = {};
        bf16x8 At[4][2], B0[2][2], B1[2][2];
        STAGE(SB(0, 0), Bt, bcol, 0); STAGE(SA(0, 0), A, brow, 0);
        STAGE(SB(0, 1), Bt, bcol + HALF, 0); STAGE(SA(0, 1), A, brow + HALF, 0);
        if (wr == 1) BAR;
        WAIT_V(4); BAR;
        STAGE(SB(1, 0), Bt, bcol, 1); STAGE(SA(1, 0), A, brow, 1); STAGE(SB(1, 1), Bt, bcol + HALF, 1);
        WAIT_V(6); BAR;
        for (int t = 0; t < nt - 2; t += 2) {
            LDB(B0, 0, 0); SCHED; LDA(At, 0, 0); STAGE(SA(1, 1), A, brow + HALF, t + 1);
            WAIT_L(8); BAR; WAIT_L(0); MMA(0, 0, At, B0); BAR; SCHED;
            LDB(B1, 0, 1); STAGE(SB(0, 0), Bt, bcol, t + 2);
            BAR; WAIT_L(0); MMA(0, 1, At, B1); BAR;
            LDA(At, 0, 1); STAGE(SA(0, 0), A, brow, t + 2);
            BAR; WAIT_L(0); MMA(1, 0, At, B0); BAR; SCHED;
            STAGE(SB(0, 1), Bt, bcol + HALF, t + 2);
            WAIT_V(6); BAR; MMA(1, 1, At, B1); BAR;
            LDB(B0, 1, 0); SCHED; LDA(At, 1, 0); STAGE(SA(0, 1), A, brow + HALF, t + 2);
            WAIT_L(8); BAR; WAIT_L(0); MMA(0, 0, At, B0); BAR; SCHED;
            LDB(B1, 1, 1); STAGE(SB(1, 0), Bt, bcol, t + 3);
            BAR; WAIT_L(0); MMA(0, 1, At, B1); BAR;
            LDA(At, 1, 1); STAGE(SA(1, 0), A, brow, t + 3);
            BAR; WAIT_L(0); MMA(1, 0, At, B0); BAR; SCHED;
            STAGE(SB(1, 1), Bt, bcol + HALF, t + 3);
            WAIT_V(6); BAR; MMA(1, 1, At, B1); BAR;
        }
        int tz = otid(); asm volatile("" : "+v"(tz)); wid = tz >> 6; lane = tz & 63; wr = wid >> 2; wc = wid & 3; fr = lane & 15; fq = lane >> 4;
        { LDB(B0, 0, 0); WAIT_V(0); LDA(At, 0, 0); STAGE_X(tz, SA(1, 1), A, brow + HALF, nt - 1);
          BAR; WAIT_L(0); MMA(0, 0, At, B0); BAR;
          LDB(B1, 0, 1); BAR; WAIT_L(0); MMA(0, 1, At, B1); BAR;
          LDA(At, 0, 1); WAIT_V(4); BAR; WAIT_L(0); MMA(1, 0, At, B0); MMA(1, 1, At, B1); BAR; }
        { LDB(B0, 1, 0); LDA(At, 1, 0); WAIT_V(2); BAR; WAIT_L(0); MMA(0, 0, At, B0); BAR;
          LDB(B1, 1, 1); WAIT_V(0); BAR; WAIT_L(0); MMA(0, 1, At, B1); BAR;
          LDA(At, 1, 1); BAR; WAIT_L(0); MMA(1, 0, At, B0); MMA(1, 1, At, B1); BAR; }
        if (wr == 0) BAR;
        __syncthreads();
        if (EPI == EPI_SCORES) {
            bf16_t* Qs = reinterpret_cast<bf16_t*>(smem);
            bf16_t* Kk = Qs + 256 * 136;
            float* rst = reinterpret_cast<float*>(Kk + 128 * 136);
            const int w8 = tz >> 6;
            if (tz < 256) {
                float s1 = 0.f, s2 = 0.f;
#pragma unroll
                for (int q = 0; q < 8; ++q) { const float2 pq = *reinterpret_cast<const float2*>(pe.zs + ((long)(brow + tz) * 8 + q) * 2); s1 += pq.x; s2 += pq.y; }
                const float mean = s1 * (1.f / DM);
                rst[tz * 2] = mean; rst[tz * 2 + 1] = rsqrtf(fmaxf(s2 * (1.f / DM) - mean * mean, 0.f) + 1e-5f);
            }
            __syncthreads();
#pragma unroll
            for (int bj = 0; bj < 2; ++bj) {
                const int jb = (bcol >> 7) + bj;
                uint4 kpre[4];
#pragma unroll
                for (int i = 0; i < 4; ++i) {
                    const int idx = tz + i * 512, row = idx >> 4, c8 = idx & 15;
                    kpre[i] = *reinterpret_cast<const uint4*>(pe.keys + ((long)jb * 128 + row) * 128 + c8 * 8);
                }
                float c1v[2], c2v[2];
#pragma unroll
                for (int n = 0; n < 2; ++n) { const int cg = bcol + bj * HALF + wc * 32 + n * 16 + fr; c1v[n] = pe.c1[cg]; c2v[n] = pe.c2[cg]; }
#pragma unroll
                for (int ai = 0; ai < 2; ++ai)
#pragma unroll
                    for (int m = 0; m < 4; ++m)
#pragma unroll
                        for (int n = 0; n < 2; ++n)
#pragma unroll
                            for (int j = 0; j < 4; ++j) {
                                const int rl = ai * HALF + wr * 64 + m * 16 + fq * 4 + j;
                                const float2 ms = *reinterpret_cast<const float2*>(rst + rl * 2);
                                Qs[rl * 136 + wc * 32 + n * 16 + fr] = f2bf(ms.y * (acc[ai][bj][m][n][j] - ms.x * c1v[n]) + c2v[n]);
                            }
#pragma unroll
                for (int i = 0; i < 4; ++i) {
                    const int idx = tz + i * 512, row = idx >> 4, c8 = idx & 15;
                    *reinterpret_cast<uint4*>(Kk + row * 136 + c8 * 8) = kpre[i];
                }
                __syncthreads();
#pragma unroll
                for (int nh = 0; nh < 2; ++nh) {
                    f32x4 sacc[2][4];
#pragma unroll
                    for (int m = 0; m < 2; ++m)
#pragma unroll
                        for (int n = 0; n < 4; ++n) sacc[m][n] = f32x4{0.f, 0.f, 0.f, 0.f};
#pragma unroll
                    for (int ks = 0; ks < 4; ++ks) {
                        const bf16x8 a0 = ldfrag(Qs, 136, w8 * 32, ks * 32, lane);
                        const bf16x8 a1 = ldfrag(Qs, 136, w8 * 32 + 16, ks * 32, lane);
#pragma unroll
                        for (int n = 0; n < 4; ++n) {
                            const bf16x8 bfr = ldfrag(Kk, 136, (nh * 4 + n) * 16, ks * 32, lane);
                            sacc[0][n] = mfma16(a0, bfr, sacc[0][n]);
                            sacc[1][n] = mfma16(a1, bfr, sacc[1][n]);
                        }
                    }
                    bf16_t* stg = reinterpret_cast<bf16_t*>(rst + 512) + w8 * 32 * 72;
#pragma unroll
                    for (int m = 0; m < 2; ++m)
#pragma unroll
                        for (int n = 0; n < 4; ++n)
#pragma unroll
                            for (int jj = 0; jj < 4; ++jj)
                                stg[(m * 16 + fq * 4 + jj) * 72 + n * 16 + fr] = f2bf(sacc[m][n][jj]);
                    wave_lds_fence();
#pragma unroll
                    for (int i = 0; i < 4; ++i) {
                        const int rrow = i * 8 + (lane >> 3), c8 = (lane & 7) * 8;
                        *reinterpret_cast<uint4*>(pe.scb + (long)(brow + w8 * 32 + rrow) * N + jb * 128 + nh * 64 + c8) =
                            *reinterpret_cast<const uint4*>(stg + rrow * 72 + c8);
                    }
                    wave_lds_fence();
                }
                __syncthreads();
            }
        } else
        {
            float* Cs = reinterpret_cast<float*>(smem);
#pragma unroll
            for (int ai = 0; ai < 2; ++ai) {
                const int c4 = (tz & 63) * 4, r0 = tz >> 6;
                uint2 rpre[16];
                float4 rc = make_float4(1.f, 1.f, 1.f, 1.f), rs = make_float4(0.f, 0.f, 0.f, 0.f);
                float4 r8c = make_float4(1.f, 1.f, 1.f, 1.f), r8s = make_float4(0.f, 0.f, 0.f, 0.f);
                if (EPI == EPI_RESID) {
#pragma unroll
                    for (int i = 0; i < 16; ++i) rpre[i] = *reinterpret_cast<const uint2*>(R + (long)(brow + ai * HALF + r0 + 8 * i) * N + bcol + c4);
                }
                if (EPI == EPI_PROJ && (bcol >> 8) <= 4) {
                    const int pos0 = (brow + ai * HALF + r0) & (SEQ - 1);
                    rc = *reinterpret_cast<const float4*>(pe.rope_cos + pos0 * 32 + (c4 & 31)); rs = *reinterpret_cast<const float4*>(pe.rope_sin + pos0 * 32 + (c4 & 31));
                    r8c = *reinterpret_cast<const float4*>(pe.rope_cos + 8 * 32 + (c4 & 31)); r8s = *reinterpret_cast<const float4*>(pe.rope_sin + 8 * 32 + (c4 & 31));
                }
#pragma unroll
                for (int bj = 0; bj < 2; ++bj)
#pragma unroll
                    for (int m = 0; m < 4; ++m)
#pragma unroll
                        for (int n = 0; n < 2; ++n)
#pragma unroll
                            for (int j = 0; j < 4; ++j)
                                Cs[(wr * 64 + m * 16 + fq * 4 + j) * 260 + bj * HALF + wc * 32 + n * 16 + fr] = acc[ai][bj][m][n][j];
                __syncthreads();
                float lb0 = 0.f, lb1 = 0.f, lb2 = 0.f, lb3 = 0.f;
                if (EPI == EPI_PROJ && ((bcol >> 8) == 7 || (bcol >> 8) == 8)) {
                    const int col = ((bcol >> 8) - 7) * 256 + c4;
                    lb0 = hgrn_lower(pe.lb, pe.l, col); lb1 = hgrn_lower(pe.lb, pe.l, col + 1);
                    lb2 = hgrn_lower(pe.lb, pe.l, col + 2); lb3 = hgrn_lower(pe.lb, pe.l, col + 3);
                }
                auto row_step = [&](int i, const uint2 rq) {
                    const int rr = r0 + 8 * i;
                    float4 v = *reinterpret_cast<const float4*>(Cs + rr * 260 + c4);
                    const long gi = (long)(brow + ai * HALF + rr) * N + bcol + c4;
                    if (EPI == EPI_PROJ) {
                        const int pn = bcol >> 8;
                        const int tok = brow + ai * HALF + rr, pos = tok & (SEQ - 1), bidx = tok >> 11;
                        if (pn <= 3 || (pn == 4 && c4 < 128)) {
                            const float4 pv = *reinterpret_cast<const float4*>(Cs + rr * 260 + (c4 ^ 32));
                            const float4 cs = rc, sn = rs;
                            rc = make_float4(cs.x * r8c.x - sn.x * r8s.x, cs.y * r8c.y - sn.y * r8s.y, cs.z * r8c.z - sn.z * r8s.z, cs.w * r8c.w - sn.w * r8s.w);
                            rs = make_float4(sn.x * r8c.x + cs.x * r8s.x, sn.y * r8c.y + cs.y * r8s.y, sn.z * r8c.z + cs.z * r8s.z, sn.w * r8c.w + cs.w * r8s.w);
                            const float sg = (c4 & 32) ? 1.f : -1.f;
                            v.x = v.x * cs.x + sg * pv.x * sn.x; v.y = v.y * cs.y + sg * pv.y * sn.y;
                            v.z = v.z * cs.z + sg * pv.z * sn.z; v.w = v.w * cs.w + sg * pv.w * sn.w;
                            if (pn <= 3) { v.x *= 0.125f; v.y *= 0.125f; v.z *= 0.125f; v.w *= 0.125f; }
                            else if (pos >= SEQ - 128)
                                *reinterpret_cast<float4*>(pe.out + O_KP + ((((long)pe.l * 4 + bidx) * 128 + (pos - (SEQ - 128))) * 2 + (c4 >> 6)) * 64 + (c4 & 63)) = v;
                        } else if (pn == 4) {
                            if (pos >= SEQ - 128)
                                *reinterpret_cast<float4*>(pe.out + O_VP + ((((long)pe.l * 4 + bidx) * 128 + (pos - (SEQ - 128))) * 2 + ((c4 - 128) >> 6)) * 64 + (c4 & 63)) = v;
                        } else if (pn == 5 || pn == 6 || pn == 11 || pn == 12 || pn == 17 || pn == 18) {
                            v.x = siluf_(v.x); v.y = siluf_(v.y); v.z = siluf_(v.z); v.w = siluf_(v.w);
                        } else if (pn == 7 || pn == 8) {
                            v.x = __logf(fmaxf(lb0 + (1.f - lb0) * sigmoidf_(v.x), 1e-30f)); v.y = __logf(fmaxf(lb1 + (1.f - lb1) * sigmoidf_(v.y), 1e-30f));
                            v.z = __logf(fmaxf(lb2 + (1.f - lb2) * sigmoidf_(v.z), 1e-30f)); v.w = __logf(fmaxf(lb3 + (1.f - lb3) * sigmoidf_(v.w), 1e-30f));
                        } else if (pn == 13) {
                            v.x *= 0.125f; v.y *= 0.125f; v.z *= 0.125f; v.w *= 0.125f;
                        }
                        uint2 pk; pk.x = pack2(v.x, v.y); pk.y = pack2(v.z, v.w);
                        *reinterpret_cast<uint2*>(Cb + gi) = pk;
                    } else if (EPI == EPI_BF16) {
                        uint2 pk; pk.x = pack2(v.x, v.y); pk.y = pack2(v.z, v.w);
                        *reinterpret_cast<uint2*>(Cb + gi) = pk;
                    } else {
                        v.x += alpha * __uint_as_float(rq.x << 16); v.y += alpha * __uint_as_float(rq.x & 0xffff0000u);
                        v.z += alpha * __uint_as_float(rq.y << 16); v.w += alpha * __uint_as_float(rq.y & 0xffff0000u);
                        uint2 pk; pk.x = pack2(v.x, v.y); pk.y = pack2(v.z, v.w);
                        *reinterpret_cast<uint2*>(Cb + gi) = pk;
                        const float s1 = wave_sum(v.x + v.y + v.z + v.w);
                        const float s2 = wave_sum(v.x * v.x + v.y * v.y + v.z * v.z + v.w * v.w);
                        if ((tz & 63) == 0) *reinterpret_cast<float2*>(pe.zs + ((long)(brow + ai * HALF + rr) * 8 + (bcol >> 8)) * 2) = make_float2(s1, s2);
                    }
                };
                if (EPI == EPI_RESID) {
#pragma unroll
                    for (int i = 0; i < 16; ++i) row_step(i, rpre[i]);
                } else {
#pragma unroll 2
                    for (int i = 0; i < 16; ++i) row_step(i, make_uint2(0u, 0u));
                }
                __syncthreads();
            }
        }
    }
    {
        const int first_light = nwg % gridDim.x, nl = gridDim.x - first_light, nsk = N / 16;
        if ((int)blockIdx.x >= first_light)
            for (int it = blockIdx.x - first_light; it < nsk; it += nl)
                skinny_item<(EPI == EPI_PROJ ? EPI_BF16 : EPI)>(A + (long)M * K, Bt, N, K, it * 16, Cb, Cf, R, alpha, pe);
    }
#undef SA
#undef SB
#undef STAGE_X
#undef STAGE
#undef LDA
#undef LDB
#undef MMA
}

template <int EPI>
__device__ __forceinline__ void skinny_item(const bf16_t* __restrict__ A  , const bf16_t* __restrict__ Bt, int N, int K, int n0,
                                            bf16_t* __restrict__ Cb, float* __restrict__ Cf, const bf16_t* __restrict__ R, float alpha, const ProjEpi pe) {
    extern __shared__ __attribute__((aligned(16))) char smem[];
    float* red = reinterpret_cast<float*>(smem);
    const int tid = otid(), lane = tid & 63, w = tid >> 6, r = lane & 15, q4 = lane >> 4;
    const int kw = K / 8;
    f32x4 acc[2] = {f32x4{0.f, 0.f, 0.f, 0.f}, f32x4{0.f, 0.f, 0.f, 0.f}};
    const bf16_t* a0 = A + (long)r * K + w * kw + q4 * 8;
    const bf16_t* a1 = A + (long)(16 + r) * K + w * kw + q4 * 8;
    const bf16_t* bp = Bt + (long)(n0 + r) * K + w * kw + q4 * 8;
    {
        bf16x8 fa0[8], fa1[8], fb[8];
#pragma unroll
        for (int ks = 0; ks < 8; ++ks) {
            fa0[ks] = *reinterpret_cast<const bf16x8*>(a0 + ks * 32);
            fa1[ks] = *reinterpret_cast<const bf16x8*>(a1 + ks * 32);
            fb[ks] = *reinterpret_cast<const bf16x8*>(bp + ks * 32);
        }
#pragma unroll
        for (int ks = 0; ks < 8; ++ks) {
            acc[0] = mfma16(fa0[ks], fb[ks], acc[0]);
            acc[1] = mfma16(fa1[ks], fb[ks], acc[1]);
        }
    }
    *reinterpret_cast<f32x4*>(red + ((w * 2 + 0) * 64 + lane) * 4) = acc[0];
    *reinterpret_cast<f32x4*>(red + ((w * 2 + 1) * 64 + lane) * 4) = acc[1];
    float* srst = red + 8 * 2 * 64 * 4;
    if (EPI == EPI_SCORES) {
        const int row = tid >> 4, part = tid & 15;
        const bf16_t* zr = pe.zb + (long)(TPROMPT + row) * K + part * 128;
        float s1 = 0.f, s2 = 0.f;
#pragma unroll
        for (int i = 0; i < 16; ++i) {
            float f[8]; unpack8(*reinterpret_cast<const uint4*>(zr + i * 8), f);
#pragma unroll
            for (int j = 0; j < 8; ++j) { s1 += f[j]; s2 += f[j] * f[j]; }
        }
        s1 = row16_sum(s1); s2 = row16_sum(s2);
        if (part == 0) { const float mean = s1 * (1.f / DM); srst[row * 2] = mean; srst[row * 2 + 1] = rsqrtf(fmaxf(s2 * (1.f / DM) - mean * mean, 0.f) + 1e-5f); }
    }
    __syncthreads();
    if (tid < 128) {
        const int mt = tid >> 6;
        f32x4 s = f32x4{0.f, 0.f, 0.f, 0.f};
#pragma unroll
        for (int ww_ = 0; ww_ < 8; ++ww_) s += *reinterpret_cast<const f32x4*>(red + ((ww_ * 2 + mt) * 64 + lane) * 4);
        float rres[4] = {0.f, 0.f, 0.f, 0.f};
        if (EPI == EPI_RESID) {
#pragma unroll
            for (int jj = 0; jj < 4; ++jj) rres[jj] = bf2f(R[(long)(TPROMPT + mt * 16 + q4 * 4 + jj) * N + n0 + r]);
        }
#pragma unroll
        for (int jj = 0; jj < 4; ++jj) {
            const int row = TPROMPT + mt * 16 + q4 * 4 + jj;
            const long gi = (long)row * N + n0 + r;
            if (EPI == EPI_BF16) Cb[gi] = f2bf(s[jj]);
            else if (EPI == EPI_SCORES) {
                const float mean = srst[(mt * 16 + q4 * 4 + jj) * 2], rstd = srst[(mt * 16 + q4 * 4 + jj) * 2 + 1];
                Cb[gi] = f2bf(rstd * (s[jj] - mean * pe.c1[n0 + r]) + pe.c2[n0 + r]);
            } else {
                const float z = s[jj] + alpha * rres[jj];
                Cb[gi] = f2bf(z);
            }
        }
    }
    __syncthreads();
}

__device__ __forceinline__ unsigned pair_lo(unsigned a, unsigned b) { return (a & 0xffffu) | (b << 16); }
__device__ __forceinline__ unsigned pair_hi(unsigned a, unsigned b) { return (a >> 16) | (b & 0xffff0000u); }
__device__ __forceinline__ void store_pairs_T(unsigned* dst, int stride_dw, const uint4 a, const uint4 b) {
    dst[0 * stride_dw] = pair_lo(a.x, b.x); dst[1 * stride_dw] = pair_hi(a.x, b.x);
    dst[2 * stride_dw] = pair_lo(a.y, b.y); dst[3 * stride_dw] = pair_hi(a.y, b.y);
    dst[4 * stride_dw] = pair_lo(a.z, b.z); dst[5 * stride_dw] = pair_hi(a.z, b.z);
    dst[6 * stride_dw] = pair_lo(a.w, b.w); dst[7 * stride_dw] = pair_hi(a.w, b.w);
}
__device__ __forceinline__ void attn_prompt_item(const Params& p, int l, int item) {
    extern __shared__ __attribute__((aligned(16))) char smem[];
    bf16_t* Ks = reinterpret_cast<bf16_t*>(smem);
    bf16_t* Vt = Ks + 256 * 72;
    bf16_t* Ps = Vt + 64 * 264;
    const int tid = otid(), lane = tid & 63, w = __builtin_amdgcn_readfirstlane(tid >> 6);
    const int hq2 = item & 1, g = (item >> 1) & 1, blk = (item >> 2) & 15, b = item >> 6;
    const long tokw = (long)b * SEQ + (blk - 1) * 128;
    const uint4 z4 = make_uint4(0u, 0u, 0u, 0u);
    {
        const int c8 = tid & 7, j0 = tid >> 3;
        const bool lo_ok = blk > 0;
        const bf16_t* kp = p.PROJ + C_KA + g * 64 + c8 * 8;
        const uint4 k0 = *reinterpret_cast<const uint4*>(kp + (tokw + (lo_ok ? j0 : 128)) * NINP);
        const uint4 k1 = *reinterpret_cast<const uint4*>(kp + (tokw + (lo_ok ? j0 + 64 : 128)) * NINP);
        const uint4 k2 = *reinterpret_cast<const uint4*>(kp + (tokw + j0 + 128) * NINP);
        const uint4 k3 = *reinterpret_cast<const uint4*>(kp + (tokw + j0 + 192) * NINP);
        const int jp = tid & 127, eg = tid >> 7;
        const bool vok = (blk > 0) || (jp >= 64);
        const bf16_t* v0 = p.PROJ + (tokw + 2 * (vok ? jp : 64)) * NINP + C_VA + g * 64 + eg * 16;
        uint4 a0 = *reinterpret_cast<const uint4*>(v0), a1 = *reinterpret_cast<const uint4*>(v0 + 8);
        uint4 b0 = *reinterpret_cast<const uint4*>(v0 + NINP), b1 = *reinterpret_cast<const uint4*>(v0 + NINP + 8);
        __builtin_amdgcn_sched_barrier(0);
        const unsigned km = lo_ok ? 0xffffffffu : 0u;
        *reinterpret_cast<uint4*>(Ks + j0 * 72 + c8 * 8) = make_uint4(k0.x & km, k0.y & km, k0.z & km, k0.w & km);
        *reinterpret_cast<uint4*>(Ks + (j0 + 64) * 72 + c8 * 8) = make_uint4(k1.x & km, k1.y & km, k1.z & km, k1.w & km);
        *reinterpret_cast<uint4*>(Ks + (j0 + 128) * 72 + c8 * 8) = k2;
        *reinterpret_cast<uint4*>(Ks + (j0 + 192) * 72 + c8 * 8) = k3;
        const unsigned vm = vok ? 0xffffffffu : 0u;
        a0 = make_uint4(a0.x & vm, a0.y & vm, a0.z & vm, a0.w & vm); a1 = make_uint4(a1.x & vm, a1.y & vm, a1.z & vm, a1.w & vm);
        b0 = make_uint4(b0.x & vm, b0.y & vm, b0.z & vm, b0.w & vm); b1 = make_uint4(b1.x & vm, b1.y & vm, b1.z & vm, b1.w & vm);
        unsigned* vd = reinterpret_cast<unsigned*>(Vt) + (eg * 16) * 132 + jp;
        store_pairs_T(vd, 132, a0, b0);
        store_pairs_T(vd + 8 * 132, 132, a1, b1);
    }
    __syncthreads();
    const int r = lane & 15, q4 = lane >> 4;
    const int i0 = w * 16;
    const int lo = (blk == 0 && w < 8) ? 8 : w, hi = w + 8;
    const int tlo = lo & ~1, thi = hi | 1;
    bf16_t* Pw = Ps + w * 16 * 264;
    const bf16_t* qbase = p.PROJ + ((long)b * SEQ + blk * 128 + i0 + r) * NINP + C_QA + (g * 8 + hq2 * 4) * 64 + q4 * 8;
    bf16x8 qn[2];
    qn[0] = *reinterpret_cast<const bf16x8*>(qbase);
    qn[1] = *reinterpret_cast<const bf16x8*>(qbase + 32);
    if (blk > 0) {
        const int tb = w & ~1;
        const int zt = (w & 1) ? (w - 1) : (w + 9);
        for (int hh = 0; hh < 4; ++hh) {
            const int qh = g * 8 + hq2 * 4 + hh;
            bf16x8 qa[2];
            qa[0] = qn[0]; qa[1] = qn[1];
            if (hh < 3) {
                qn[0] = *reinterpret_cast<const bf16x8*>(qbase + (hh + 1) * 64);
                qn[1] = *reinterpret_cast<const bf16x8*>(qbase + (hh + 1) * 64 + 32);
            }
            f32x4 acc[9];
#pragma unroll
            for (int rt = 0; rt < 9; ++rt) {
                acc[rt] = f32x4{0.f, 0.f, 0.f, 0.f};
#pragma unroll
                for (int ks = 0; ks < 2; ++ks) acc[rt] = mfma16(qa[ks], ldfrag(Ks, 72, (w + rt) * 16, ks * 32, lane), acc[rt]);
            }
            const float sink = p.sinks[l * 16 + qh];
#pragma unroll
            for (int jj = 0; jj < 4; ++jj) {
                const int qi = q4 * 4 + jj;
                const float s0 = (r >= qi) ? acc[0][jj] : -1e30f, s8 = (r <= qi) ? acc[8][jj] : -1e30f;
                float m = fmaxf(s0, s8);
#pragma unroll
                for (int rt = 1; rt < 8; ++rt) m = fmaxf(m, acc[rt][jj]);
                m = row16_max(m); m = fmaxf(m, sink);
                float pv[9];
                pv[0] = __expf(s0 - m); pv[8] = __expf(s8 - m);
                float sum = pv[0] + pv[8];
#pragma unroll
                for (int rt = 1; rt < 8; ++rt) { pv[rt] = __expf(acc[rt][jj] - m); sum += pv[rt]; }
                sum = row16_sum(sum);
                const float inv = __builtin_amdgcn_rcpf(sum + __expf(sink - m));
                bf16_t* prow = Pw + qi * 264 + w * 16 + r;
#pragma unroll
                for (int rt = 0; rt < 9; ++rt) prow[rt * 16] = f2bf(pv[rt] * inv);
                Pw[qi * 264 + zt * 16 + r] = 0;
            }
            wave_lds_fence();
            f32x4 o[4];
#pragma unroll
            for (int nt = 0; nt < 4; ++nt) o[nt] = f32x4{0.f, 0.f, 0.f, 0.f};
#pragma unroll
            for (int c = 0; c < 5; ++c) {
                const int k0 = (tb * 16) + c * 32;
                const bf16x8 pa = ldfrag(Pw, 264, 0, k0, lane);
#pragma unroll
                for (int nt = 0; nt < 4; ++nt) o[nt] = mfma16(pa, ldfrag(Vt, 264, nt * 16, k0, lane), o[nt]);
            }
#pragma unroll
            for (int nt = 0; nt < 4; ++nt)
#pragma unroll
                for (int jj = 0; jj < 4; ++jj) {
                    const long tok = (long)b * SEQ + blk * 128 + i0 + q4 * 4 + jj;
                    p.OCAT[tok * DM + qh * 64 + nt * 16 + r] = f2bf(o[nt][jj]);
                }
            wave_lds_fence();
        }
    } else {
    for (int hh = 0; hh < 4; ++hh) {
        const int qh = g * 8 + hq2 * 4 + hh;
        bf16x8 qa[2];
        qa[0] = qn[0]; qa[1] = qn[1];
        if (hh < 3) {
            qn[0] = *reinterpret_cast<const bf16x8*>(qbase + (hh + 1) * 64);
            qn[1] = *reinterpret_cast<const bf16x8*>(qbase + (hh + 1) * 64 + 32);
        }
        f32x4 acc[16];
#pragma unroll
        for (int nt = 0; nt < 16; ++nt) {
            acc[nt] = f32x4{0.f, 0.f, 0.f, 0.f};
            if (nt >= lo && nt <= hi) {
#pragma unroll
                for (int ks = 0; ks < 2; ++ks) acc[nt] = mfma16(qa[ks], ldfrag(Ks, 72, nt * 16, ks * 32, lane), acc[nt]);
            }
        }
        const float sink = p.sinks[l * 16 + qh];
#pragma unroll
        for (int jj = 0; jj < 4; ++jj) {
            const int i = i0 + q4 * 4 + jj;
            float m = -1e30f;
#pragma unroll
            for (int nt = 0; nt < 16; ++nt) {
                if (nt >= tlo && nt <= thi) {
                    const int j = nt * 16 + r, diff = i + 128 - j;
                    const bool valid = (diff >= 0) && (diff <= 128) && (blk > 0 || j >= 128);
                    const float s = valid ? acc[nt][jj] : -1e30f;
                    acc[nt][jj] = s; m = fmaxf(m, s);
                }
            }
            m = row16_max(m); m = fmaxf(m, sink);
            float sum = 0.f;
#pragma unroll
            for (int nt = 0; nt < 16; ++nt) {
                if (nt >= tlo && nt <= thi) {
                    const float s = acc[nt][jj];
                    const float pv = (s > -1e29f) ? __expf(s - m) : 0.f;
                    acc[nt][jj] = pv; sum += pv;
                }
            }
            sum = row16_sum(sum);
            const float inv = 1.f / (sum + __expf(sink - m));
#pragma unroll
            for (int nt = 0; nt < 16; ++nt)
                if (nt >= tlo && nt <= thi) Pw[(q4 * 4 + jj) * 264 + nt * 16 + r] = f2bf(acc[nt][jj] * inv);
        }
        wave_lds_fence();
        f32x4 o[4];
#pragma unroll
        for (int nt = 0; nt < 4; ++nt) o[nt] = f32x4{0.f, 0.f, 0.f, 0.f};
#pragma unroll
        for (int ks = 0; ks < 8; ++ks) {
            if (ks >= (tlo >> 1) && ks <= (thi >> 1)) {
                const bf16x8 pa = ldfrag(Pw, 264, 0, ks * 32, lane);
#pragma unroll
                for (int nt = 0; nt < 4; ++nt) o[nt] = mfma16(pa, ldfrag(Vt, 264, nt * 16, ks * 32, lane), o[nt]);
            }
        }
#pragma unroll
        for (int nt = 0; nt < 4; ++nt)
#pragma unroll
            for (int jj = 0; jj < 4; ++jj) {
                const long tok = (long)b * SEQ + blk * 128 + i0 + q4 * 4 + jj;
                p.OCAT[tok * DM + qh * 64 + nt * 16 + r] = f2bf(o[nt][jj]);
            }
        wave_lds_fence();
    }
    }
    __syncthreads();
}

__device__ __forceinline__ void attn_sample_wave(const Params& p, int l, int item, float* wl) {
    const int lane = otid() & 63;
    const int b = item >> 4, qh = item & 15, g = qh >> 3;
    const long tok = TPROMPT + b;
    const bf16_t* pr = p.PROJ + tok * NINP;
    const float* cs = p.rope_cos + 2048 * 32;
    const float* sn = p.rope_sin + 2048 * 32;
    float* qs = wl; float* kn = wl + 64; float* vn = wl + 128;
    {
        const int d = lane, dp = d & 31;
        const float c = cs[dp], s = sn[dp];
        const float x1 = bf2f(pr[C_QA + qh * 64 + dp]), x2 = bf2f(pr[C_QA + qh * 64 + 32 + dp]);
        qs[d] = ((d < 32) ? (x1 * c - x2 * s) : (x2 * c + x1 * s)) * 0.125f;
        const float k1 = bf2f(pr[C_KA + g * 64 + dp]), k2 = bf2f(pr[C_KA + g * 64 + 32 + dp]);
        kn[d] = (d < 32) ? (k1 * c - k2 * s) : (k2 * c + k1 * s);
        vn[d] = bf2f(pr[C_VA + g * 64 + d]);
    }
    wave_lds_fence();
    const float* ck = p.cache_k + ((long)(l * 32 + b) * 128) * 128 + g * 64;
    const float* cv = p.cache_v + ((long)(l * 32 + b) * 128) * 128 + g * 64;
    float* ok = p.out + O_KS + ((long)(l * 32 + b) * 128) * 128 + g * 64;
    float* ov = p.out + O_VS + ((long)(l * 32 + b) * 128) * 128 + g * 64;
    const int jr = lane >> 4, c4 = (lane & 15) * 4;
    const int sel = qh & 7;
    const float4 q4v = *reinterpret_cast<const float4*>(qs + c4);
    const float4 kn4 = *reinterpret_cast<const float4*>(kn + c4);
    const float4 vn4 = *reinterpret_cast<const float4*>(vn + c4);
    float4 kv[32];
#pragma unroll
    for (int i = 0; i < 32; ++i) kv[i] = *reinterpret_cast<const float4*>(ck + (long)(4 * i + jr) * 128 + c4);
    float sc[32];
    float m = -3.0e38f;
#pragma unroll
    for (int i = 0; i < 32; ++i) {
        sc[i] = row16_sum(q4v.x * kv[i].x + q4v.y * kv[i].y + q4v.z * kv[i].z + q4v.w * kv[i].w);
        m = fmaxf(m, sc[i]);
        if ((i >> 2) == sel) { const int j = 4 * i + jr; if (j >= 1) *reinterpret_cast<float4*>(ok + (long)(j - 1) * 128 + c4) = kv[i]; }
    }
    const float s2 = row16_sum(q4v.x * kn4.x + q4v.y * kn4.y + q4v.z * kn4.z + q4v.w * kn4.w);
    const float sink = p.sinks[l * 16 + qh];
    m = fmaxf(fmaxf(rdlane(m, 0), rdlane(m, 16)), fmaxf(rdlane(m, 32), rdlane(m, 48)));
    m = fmaxf(m, fmaxf(s2, sink));
    float4 vv[32];
#pragma unroll
    for (int i = 0; i < 32; ++i) vv[i] = *reinterpret_cast<const float4*>(cv + (long)(4 * i + jr) * 128 + c4);
    float lsum = 0.f;
#pragma unroll
    for (int i = 0; i < 32; ++i) { sc[i] = __expf(sc[i] - m); lsum += sc[i]; }
    const float p2 = __expf(s2 - m);
    const float den = (rdlane(lsum, 0) + rdlane(lsum, 16)) + (rdlane(lsum, 32) + rdlane(lsum, 48)) + p2 + __expf(sink - m);
    const float inv = 1.f / den;
    float4 o4 = make_float4(0.f, 0.f, 0.f, 0.f);
#pragma unroll
    for (int i = 0; i < 32; ++i) {
        o4.x += sc[i] * vv[i].x; o4.y += sc[i] * vv[i].y; o4.z += sc[i] * vv[i].z; o4.w += sc[i] * vv[i].w;
        if ((i >> 2) == sel) { const int j = 4 * i + jr; if (j >= 1) *reinterpret_cast<float4*>(ov + (long)(j - 1) * 128 + c4) = vv[i]; }
    }
    o4.x += __shfl_xor(o4.x, 16); o4.y += __shfl_xor(o4.y, 16); o4.z += __shfl_xor(o4.z, 16); o4.w += __shfl_xor(o4.w, 16);
    o4.x += __shfl_xor(o4.x, 32); o4.y += __shfl_xor(o4.y, 32); o4.z += __shfl_xor(o4.z, 32); o4.w += __shfl_xor(o4.w, 32);
    if (jr == 0) {
        uint2 pk;
        pk.x = pack2((o4.x + p2 * vn4.x) * inv, (o4.y + p2 * vn4.y) * inv);
        pk.y = pack2((o4.z + p2 * vn4.z) * inv, (o4.w + p2 * vn4.w) * inv);
        *reinterpret_cast<uint2*>(p.OCAT + tok * DM + qh * 64 + c4) = pk;
        if (sel == 7) {
            *reinterpret_cast<float4*>(ok + 127L * 128 + c4) = kn4;
            *reinterpret_cast<float4*>(ov + 127L * 128 + c4) = vn4;
        }
    }
    wave_lds_fence();
}

template <int KIND>
__device__ __forceinline__ float log_decay_raw(const Params& p, int l, const bf16_t* pr, int h, int d, float& kval) {
    if (KIND == 0) {
        const int col = h * 128 + d;
        const float z = bf2f(pr[C_FB + col]);
        const float lb = hgrn_lower(p.lb_logits, l, col);
        const float f = lb + (1.f - lb) * sigmoidf_(z);
        kval = 1.f - f;
        return __logf(fmaxf(f, 1e-30f));
    } else {
        const int col = h * 64 + d;
        float ac[16], wa[16];
        unpack8(*reinterpret_cast<const uint4*>(pr + C_AC), ac); unpack8(*reinterpret_cast<const uint4*>(pr + C_AC + 8), ac + 8);
#pragma unroll
        for (int r = 0; r < 16; ++r) wa[r] = p.gla_wa2[(l * 16 + r) * 256 + col];
        float a = p.gla_ba[l * 256 + col];
#pragma unroll
        for (int r = 0; r < 16; ++r) a += ac[r] * wa[r];
        kval = bf2f(pr[C_KC + col]);
        return logsigmoidf_(a) * (1.f / 16.f);
    }
}
template <int CTRL> __device__ __forceinline__ float dpp_zero(float v) {
    return __int_as_float(__builtin_amdgcn_update_dpp(0, __float_as_int(v), CTRL, 0xf, 0xf, true));
}
__device__ __forceinline__ float scan32(float x) {
    x += dpp_zero<0x111>(x); x += dpp_zero<0x112>(x); x += dpp_zero<0x114>(x); x += dpp_zero<0x118>(x);
    x += __int_as_float(__builtin_amdgcn_update_dpp(0, __float_as_int(x), 0x142, 0xA, 0xf, false));
    return x;
}
template <int KIND>
struct ChunkDecay { float b0[8], b1[8], k0[8], k1[8]; };
template <int KIND, bool STORE_LFC>
__device__ __forceinline__ void chunk_decay(const Params& p, int l, long tokp, int h, int dg, ChunkDecay<KIND>& cd) {
    const bf16_t* pr0 = p.PROJ + tokp * NINP;
    const bf16_t* pr1 = pr0 + NINP;
    float lf0[8], lf1[8];
    if (KIND == 0) {
        unpack8(*reinterpret_cast<const uint4*>(pr0 + C_FB + h * 128 + dg * 8), lf0);
        unpack8(*reinterpret_cast<const uint4*>(pr1 + C_FB + h * 128 + dg * 8), lf1);
#pragma unroll
        for (int i = 0; i < 8; ++i) { cd.k0[i] = 1.f - __expf(lf0[i]); cd.k1[i] = 1.f - __expf(lf1[i]); }
    } else {
        unpack8(*reinterpret_cast<const uint4*>(pr0 + C_KC + h * 64 + dg * 8), cd.k0);
        unpack8(*reinterpret_cast<const uint4*>(pr1 + C_KC + h * 64 + dg * 8), cd.k1);
        if (STORE_LFC) {
            float a0[16], a1[16];
            unpack8(*reinterpret_cast<const uint4*>(pr0 + C_AC), a0); unpack8(*reinterpret_cast<const uint4*>(pr0 + C_AC + 8), a0 + 8);
            unpack8(*reinterpret_cast<const uint4*>(pr1 + C_AC), a1); unpack8(*reinterpret_cast<const uint4*>(pr1 + C_AC + 8), a1 + 8);
            const float* wa = p.gla_wa2 + (long)l * 16 * 256 + h * 64 + dg * 8;
            const float* ba = p.gla_ba + l * 256 + h * 64 + dg * 8;
            float g0[8], g1[8];
#pragma unroll
            for (int i = 0; i < 8; ++i) { g0[i] = ba[i]; g1[i] = ba[i]; }
#pragma unroll
            for (int r = 0; r < 16; ++r) {
                const float4 w0 = *reinterpret_cast<const float4*>(wa + r * 256), w1 = *reinterpret_cast<const float4*>(wa + r * 256 + 4);
                const float wv[8] = {w0.x, w0.y, w0.z, w0.w, w1.x, w1.y, w1.z, w1.w};
#pragma unroll
                for (int i = 0; i < 8; ++i) { g0[i] += a0[r] * wv[i]; g1[i] += a1[r] * wv[i]; }
            }
#pragma unroll
            for (int i = 0; i < 8; ++i) { g0[i] = logsigmoidf_(g0[i]) * (1.f / 16.f); g1[i] = logsigmoidf_(g1[i]) * (1.f / 16.f); }
            const uint4 u0 = pack8(g0), u1 = pack8(g1);
            *reinterpret_cast<uint4*>(p.LFC + tokp * 256 + h * 64 + dg * 8) = u0;
            *reinterpret_cast<uint4*>(p.LFC + (tokp + 1) * 256 + h * 64 + dg * 8) = u1;
            unpack8(u0, lf0); unpack8(u1, lf1);
        } else {
            unpack8(*reinterpret_cast<const uint4*>(p.LFC + tokp * 256 + h * 64 + dg * 8), lf0);
            unpack8(*reinterpret_cast<const uint4*>(p.LFC + (tokp + 1) * 256 + h * 64 + dg * 8), lf1);
        }
    }
#pragma unroll
    for (int i = 0; i < 8; ++i) {
        const float p1 = lf0[i] + lf1[i];
        const float S = scan32(p1);
        cd.b0[i] = S - lf1[i];
        cd.b1[i] = S;
    }
}

template <int KIND>
__device__ __forceinline__ void rec_local_item(const Params& p, int l, int item) {
    constexpr int DK = KIND == 0 ? 128 : 64, NDT = DK / 16;
    constexpr int VOFF = KIND == 0 ? C_IB : C_VC;
    extern __shared__ __attribute__((aligned(16))) char smem[];
    bf16_t* kdT = reinterpret_cast<bf16_t*>(smem);
    bf16_t* vT = kdT + DK * 72;
    const int tid = otid(), lane = tid & 63, w = __builtin_amdgcn_readfirstlane(tid >> 6), sp = tid & 31, dg = tid >> 5;
    const int c = item & 31, h = (item >> 5) & 3, b = item >> 7, bh = b * 4 + h;
    const long tok0 = (long)b * SEQ + c * 64;
    const long tokp = tok0 + 2 * sp;
    {
        const bf16_t* v0 = p.PROJ + tokp * NINP + VOFF + h * 128 + dg * 8;
        store_pairs_T(reinterpret_cast<unsigned*>(vT) + (dg * 8) * 36 + sp, 36,
                      *reinterpret_cast<const uint4*>(v0), *reinterpret_cast<const uint4*>(v0 + NINP));
    }
    if (w < DK / 16) {
        ChunkDecay<KIND> cd;
        chunk_decay<KIND, true>(p, l, tokp, h, dg, cd);
        float* Dg = (KIND == 0 ? p.HD : p.GD) + (long)(bh * 32 + c) * DK + dg * 8;
        unsigned* kd = reinterpret_cast<unsigned*>(kdT) + (dg * 8) * 36 + sp;
#pragma unroll
        for (int i = 0; i < 8; ++i) {
            const float be = (lane < 32) ? rdlane(cd.b1[i], 31) : rdlane(cd.b1[i], 63);
            kd[i * 36] = pack2(cd.k0[i] * __expf(be - cd.b0[i]), cd.k1[i] * __expf(be - cd.b1[i]));
            if (sp == 0) Dg[i] = __expf(be);
        }
    }
    __syncthreads();
    f32x4 acc[NDT];
#pragma unroll
    for (int n = 0; n < NDT; ++n) acc[n] = f32x4{0.f, 0.f, 0.f, 0.f};
#pragma unroll
    for (int ks = 0; ks < 2; ++ks) {
        const bf16x8 a = ldfrag(vT, 72, w * 16, ks * 32, lane);
#pragma unroll
        for (int n = 0; n < NDT; ++n) acc[n] = mfma16(a, ldfrag(kdT, 72, n * 16, ks * 32, lane), acc[n]);
    }
    bf16_t* ST = (KIND == 0 ? p.HST : p.GST) + ((long)bh * 33 + c + 1) * DK * 128;
    bf16_t* stg = vT + 128 * 72;
    const int r = lane & 15, q4 = lane >> 4;
#pragma unroll
    for (int n = 0; n < NDT; ++n)
#pragma unroll
        for (int jj = 0; jj < 4; ++jj) stg[(w * 16 + q4 * 4 + jj) * (DK + 8) + n * 16 + r] = f2bf(acc[n][jj]);
    __syncthreads();
#pragma unroll
    for (int i = 0; i < DK / 32; ++i) {
        const int idx = tid + i * 512, e = idx / (DK / 8), c8 = (idx % (DK / 8)) * 8;
        *reinterpret_cast<uint4*>(ST + e * DK + c8) = *reinterpret_cast<const uint4*>(stg + e * (DK + 8) + c8);
    }
    __syncthreads();
}

template <int KIND>
__device__ __forceinline__ void rec_out_item(const Params& p, int l, int item) {
    constexpr int DK = KIND == 0 ? 128 : 64, QS = DK + 8, NKS = DK / 32, EPT = DK / 4;
    constexpr int VOFF = KIND == 0 ? C_IB : C_VC, GOFF = KIND == 0 ? C_GB : C_GC, QOFF = KIND == 0 ? C_QB : C_QC;
    extern __shared__ __attribute__((aligned(16))) char smem[];
    float* Os = reinterpret_cast<float*>(smem);
    bf16_t* qr = reinterpret_cast<bf16_t*>(smem + 33792);
    bf16_t* kr = qr + 64 * QS;
    bf16_t* STt = kr + 64 * QS;
    bf16_t* vT = STt + 128 * QS;
    bf16_t* aP = vT + 128 * 72;
    float* erv = reinterpret_cast<float*>(aP + 64 * 72);
    const int tid = otid(), lane = tid & 63, w = __builtin_amdgcn_readfirstlane(tid >> 6), sp = tid & 31, dg = tid >> 5;
    const int c = item & 31, h = (item >> 5) & 3, b = item >> 7, bh = b * 4 + h;
    const long tok0 = (long)b * SEQ + c * 64;
    const long tokp = tok0 + 2 * sp;
    const float* nw = (KIND == 0 ? p.hgrn_nw : p.gla_nw) + (l * 4 + h) * 128;
    const float nw0 = nw[lane], nw1 = nw[lane + 64];
    bf16_t gq0[8], gq1[8];
#pragma unroll
    for (int i = 0; i < 8; ++i) {
        const bf16_t* pr = p.PROJ + (tok0 + w * 8 + i) * NINP + GOFF + h * 128;
        gq0[i] = pr[lane]; gq1[i] = pr[lane + 64];
    }
    uint4 stv[EPT / 8];
    {
        const bf16_t* ST = (KIND == 0 ? p.HST : p.GST) + ((long)bh * 33 + c) * DK * 128;
        const int e = tid >> 2, d0 = (tid & 3) * EPT;
#pragma unroll
        for (int u = 0; u < EPT / 8; ++u) stv[u] = *reinterpret_cast<const uint4*>(ST + e * DK + d0 + u * 8);
    }
    {
        const bf16_t* v0 = p.PROJ + tokp * NINP + VOFF + h * 128 + dg * 8;
        store_pairs_T(reinterpret_cast<unsigned*>(vT) + (dg * 8) * 36 + sp, 36,
                      *reinterpret_cast<const uint4*>(v0), *reinterpret_cast<const uint4*>(v0 + NINP));
    }
    if (w < DK / 16) {
        ChunkDecay<KIND> cd;
        chunk_decay<KIND, false>(p, l, tokp, h, dg, cd);
        float q0[8], q1[8];
        unpack8(*reinterpret_cast<const uint4*>(p.PROJ + tokp * NINP + QOFF + h * DK + dg * 8), q0);
        unpack8(*reinterpret_cast<const uint4*>(p.PROJ + (tokp + 1) * NINP + QOFF + h * DK + dg * 8), q1);
        float a0[8], a1[8], c0[8], c1[8];
#pragma unroll
        for (int i = 0; i < 8; ++i) {
            const float rr = (lane < 32) ? rdlane(cd.b1[i], 15) : rdlane(cd.b1[i], 47);
            a0[i] = q0[i] * __expf(fminf(cd.b0[i] - rr, 80.f)); a1[i] = q1[i] * __expf(fminf(cd.b1[i] - rr, 80.f));
            c0[i] = cd.k0[i] * __expf(fminf(rr - cd.b0[i], 80.f)); c1[i] = cd.k1[i] * __expf(fminf(rr - cd.b1[i], 80.f));
            if (sp == 0) erv[dg * 8 + i] = __expf(rr);
        }
        *reinterpret_cast<uint4*>(qr + (2 * sp) * QS + dg * 8) = pack8(a0);
        *reinterpret_cast<uint4*>(qr + (2 * sp + 1) * QS + dg * 8) = pack8(a1);
        *reinterpret_cast<uint4*>(kr + (2 * sp) * QS + dg * 8) = pack8(c0);
        *reinterpret_cast<uint4*>(kr + (2 * sp + 1) * QS + dg * 8) = pack8(c1);
    }
    __syncthreads();
    {
        const int e = tid >> 2, d0 = (tid & 3) * EPT;
#pragma unroll
        for (int u = 0; u < EPT / 8; ++u) {
            float sf[8]; unpack8(stv[u], sf);
            const float4 r0 = *reinterpret_cast<const float4*>(erv + d0 + u * 8);
            const float4 r1 = *reinterpret_cast<const float4*>(erv + d0 + u * 8 + 4);
            const float f[8] = {sf[0] * r0.x, sf[1] * r0.y, sf[2] * r0.z, sf[3] * r0.w, sf[4] * r1.x, sf[5] * r1.y, sf[6] * r1.z, sf[7] * r1.w};
            *reinterpret_cast<uint4*>(STt + e * QS + d0 + u * 8) = pack8(f);
        }
    }
    const int r = lane & 15, q4 = lane >> 4;
    {
        const int rt = w >> 1, ct0 = (w & 1) * 2;
        f32x4 a2[2] = {f32x4{0.f, 0.f, 0.f, 0.f}, f32x4{0.f, 0.f, 0.f, 0.f}};
#pragma unroll
        for (int ks = 0; ks < NKS; ++ks) {
            const bf16x8 a = ldfrag(qr, QS, rt * 16, ks * 32, lane);
#pragma unroll
            for (int n = 0; n < 2; ++n) a2[n] = mfma16(a, ldfrag(kr, QS, (ct0 + n) * 16, ks * 32, lane), a2[n]);
        }
#pragma unroll
        for (int n = 0; n < 2; ++n)
#pragma unroll
            for (int jj = 0; jj < 4; ++jj) {
                const int t = rt * 16 + q4 * 4 + jj, s = (ct0 + n) * 16 + r;
                aP[t * 72 + s] = f2bf((s <= t) ? a2[n][jj] : 0.f);
            }
    }
    __syncthreads();
    {
        const int rt = w & 3, nt0 = (w >> 2) * 4;
        f32x4 acc[4];
#pragma unroll
        for (int n = 0; n < 4; ++n) acc[n] = f32x4{0.f, 0.f, 0.f, 0.f};
#pragma unroll
        for (int ks = 0; ks < NKS; ++ks) {
            const bf16x8 a = ldfrag(qr, QS, rt * 16, ks * 32, lane);
#pragma unroll
            for (int n = 0; n < 4; ++n) acc[n] = mfma16(a, ldfrag(STt, QS, (nt0 + n) * 16, ks * 32, lane), acc[n]);
        }
#pragma unroll
        for (int ks = 0; ks < 2; ++ks) {
            const bf16x8 a = ldfrag(aP, 72, rt * 16, ks * 32, lane);
#pragma unroll
            for (int n = 0; n < 4; ++n) acc[n] = mfma16(a, ldfrag(vT, 72, (nt0 + n) * 16, ks * 32, lane), acc[n]);
        }
#pragma unroll
        for (int n = 0; n < 4; ++n)
#pragma unroll
            for (int jj = 0; jj < 4; ++jj) Os[(rt * 16 + q4 * 4 + jj) * 132 + (nt0 + n) * 16 + r] = acc[n][jj];
    }
    __syncthreads();
    {
#pragma unroll
        for (int i = 0; i < 8; ++i) {
            const int t = w * 8 + i;
            const float x0 = Os[t * 132 + lane], x1 = Os[t * 132 + 64 + lane];
            const float ss = wave_sum(x0 * x0 + x1 * x1);
            const float inv = rsqrtf(ss * (1.f / 128.f) + 1e-6f);
            bf16_t* oc = p.OCAT + (tok0 + t) * DM + 1024 + KIND * 512 + h * 128;
            oc[lane] = f2bf(x0 * inv * nw0 * bf2f(gq0[i]));
            oc[lane + 64] = f2bf(x1 * inv * nw1 * bf2f(gq1[i]));
        }
    }
    __syncthreads();
}

template <int KIND>
__device__ __forceinline__ void rec_sample_item(const Params& p, int l, int item) {
    constexpr int DK = KIND == 0 ? 128 : 64;
    constexpr int VOFF = KIND == 0 ? C_IB : C_VC, GOFF = KIND == 0 ? C_GB : C_GC;
    extern __shared__ __attribute__((aligned(16))) char smem[];
    float* av = reinterpret_cast<float*>(smem);
    float* kv = av + 128;
    float* qv = kv + 128;
    float* red = qv + 128;
    float* ov = red + 512;
    const int tid = otid(), lane = tid & 63;
    const int h = item & 3, b = item >> 2;
    const long tok = TPROMPT + b;
    const bf16_t* pr = p.PROJ + tok * NINP;
    if (tid < DK) {
        float k; const float lf = log_decay_raw<KIND>(p, l, pr, h, tid, k);
        av[tid] = __expf(lf); kv[tid] = k;
        if (KIND == 0) qv[tid] = siluf_(bf2f(pr[C_QB + h * 128 + tid]));
        else qv[tid] = bf2f(pr[C_QC + h * 64 + tid]) * 0.125f;
    }
    __syncthreads();
    const int e = tid & 127, dg = tid >> 7;
    const float v = bf2f(pr[VOFF + h * 128 + e]);
    const float* S0 = (KIND == 0 ? p.state_hgrn : p.state_gla) + ((long)(l * 32 + b) * 4 + h) * DK * 128;
    float* S1 = p.out + (KIND == 0 ? O_HS : O_GS) + ((long)(l * 32 + b) * 4 + h) * DK * 128;
    float o = 0.f;
    {
        constexpr int ND = DK / 4;
        const int d0 = dg * ND;
        float s0v[ND];
#pragma unroll
        for (int i = 0; i < ND; ++i) s0v[i] = S0[(d0 + i) * 128 + e];
#pragma unroll
        for (int i = 0; i < ND; ++i) {
            const float sn = av[d0 + i] * s0v[i] + kv[d0 + i] * v;
            S1[(d0 + i) * 128 + e] = sn;
            o += qv[d0 + i] * sn;
        }
    }
    red[dg * 128 + e] = o;
    __syncthreads();
    if (tid < 128) ov[tid] = red[tid] + red[128 + tid] + red[256 + tid] + red[384 + tid];
    __syncthreads();
    if (tid < 64) {
        const float x0 = ov[lane], x1 = ov[lane + 64];
        const float ss = wave_sum(x0 * x0 + x1 * x1);
        const float inv = rsqrtf(ss * (1.f / 128.f) + 1e-6f);
        const float* nw = (KIND == 0 ? p.hgrn_nw : p.gla_nw) + (l * 4 + h) * 128;
        const float g0 = bf2f(pr[GOFF + h * 128 + lane]), g1 = bf2f(pr[GOFF + h * 128 + lane + 64]);
        bf16_t* oc = p.OCAT + tok * DM + 1024 + KIND * 512 + h * 128;
        oc[lane] = f2bf(x0 * inv * nw[lane] * siluf_(g0));
        oc[lane + 64] = f2bf(x1 * inv * nw[lane + 64] * siluf_(g1));
    }
    __syncthreads();
}

__device__ __forceinline__ void ph_mix_a(const Params& p, int l) {
    extern __shared__ __attribute__((aligned(16))) char smem[];
    {
        const int tid_ = otid(), wv = tid_ >> 6, ln = tid_ & 63, kt = ln & 31;
        for (int n = blockIdx.x * 8 + wv; n < DM; n += gridDim.x * 8) {
            const float* src = (ln < 32) ? p.CP1 : p.CP2;
            float v = src[((long)l * 32 + kt) * DM + n];
            v = row16_sum(v);
            const float c1s = rdlane(v, 0) + rdlane(v, 16), c2s = rdlane(v, 32) + rdlane(v, 48);
            if (ln == 0) { p.C1[l * DM + n] = c1s; p.C2[l * DM + n] = c2s; }
        }
    }
    for (int it = blockIdx.x; it < 1600; it += gridDim.x) {
        if (it < 64) {
            const int w = __builtin_amdgcn_readfirstlane(otid() >> 6);
            attn_sample_wave(p, l, it * 8 + w, reinterpret_cast<float*>(smem) + w * 512);
            __syncthreads();
        }
        else if (it < 192) rec_sample_item<0>(p, l, it - 64);
        else if (it < 320) rec_sample_item<1>(p, l, it - 192);
        else if (it < 576) attn_prompt_item(p, l, it - 320);
        else if (it < 1088) rec_local_item<0>(p, l, it - 576);
        else rec_local_item<1>(p, l, it - 1088);
    }
}
__device__ __forceinline__ void ph_scan(const Params& p, int l) {
    const long gtid = (long)blockIdx.x * 512 + otid(), gsz = (long)gridDim.x * 512;
    for (long idx = gtid; idx < 262144L + 131072L; idx += gsz) {
        const int kind = idx >= 262144L;
        const long ii = kind ? idx - 262144L : idx;
        const int DK = kind ? 64 : 128;
        const int bh = (int)(ii / (DK * 128)), rem = (int)(ii % (DK * 128)), d = rem & (DK - 1), e = rem / DK;
        bf16_t* __restrict__ st = (kind ? p.GST : p.HST) + (long)bh * 33 * DK * 128 + rem;
        const float* __restrict__ dg = (kind ? p.GD : p.HD) + (long)bh * 32 * DK + d;
        const long cs = (long)DK * 128;
        float lsv[32], dv[32];
#pragma unroll
        for (int c = 0; c < 32; ++c) { lsv[c] = bf2f(st[(c + 1) * cs]); dv[c] = dg[c * DK]; }
        float s = 0.f; st[0] = 0;
#pragma unroll
        for (int c = 0; c < 32; ++c) { s = dv[c] * s + lsv[c]; st[(c + 1) * cs] = f2bf(s); }
        const int b = bh >> 2, h = bh & 3;
        p.out[(kind ? O_GP : O_HP) + ((long)(l * 4 + b) * 4 + h) * DK * 128 + d * 128 + e] = s;
    }
}
__device__ __forceinline__ void ph_mix_b(const Params& p, int l) {
    for (int it = blockIdx.x; it < 1024; it += gridDim.x) {
        if (it < 512) rec_out_item<0>(p, l, it);
        else rec_out_item<1>(p, l, it - 512);
    }
}

typedef float float2v __attribute__((ext_vector_type(2)));
typedef _Float16 half2v __attribute__((ext_vector_type(2)));
__device__ __forceinline__ unsigned fkey(float f) { const unsigned k = __float_as_uint(f); return (k & 0x80000000u) ? ~k : (k | 0x80000000u); }
__device__ __forceinline__ int mbcnt64(unsigned long long m) {
    return (int)__builtin_amdgcn_mbcnt_hi((unsigned)(m >> 32), __builtin_amdgcn_mbcnt_lo((unsigned)m, 0u));
}
template <int NV>
__device__ __forceinline__ void select16(const unsigned (&k)[NV], bool (&keep)[NV], int (&pos)[NV]) {
    unsigned km = k[0];
#pragma unroll
    for (int v = 1; v < NV; ++v) km = km > k[v] ? km : k[v];
    km = wave_max_u32(km);
    unsigned T = km & 0xFF800000u;
    int c0 = 0;
#pragma unroll 1
    for (;;) {
        c0 = 0;
#pragma unroll
        for (int v = 0; v < NV; ++v) c0 += __popcll(__ballot(k[v] >= T));
        if (c0 >= 16 || T < 0x00800000u) break;
        T -= 0x00800000u;
    }
    if (c0 < 16) T = 0u;
    bool exact = (c0 == 16);
    if (!exact) {
        for (int bit = 22; bit >= 0; --bit) {
            const unsigned trial = T | (1u << bit);
            int c = 0;
#pragma unroll
            for (int v = 0; v < NV; ++v) c += __popcll(__ballot(k[v] >= trial));
            if (c >= 16) { T = trial; if (c == 16) { exact = true; break; } }
        }
    }
    if (exact) {
        int pbase = 0;
#pragma unroll
        for (int v = 0; v < NV; ++v) {
            keep[v] = k[v] >= T;
            const unsigned long long K = __ballot(keep[v]);
            pos[v] = pbase + mbcnt64(K);
            pbase += __popcll(K);
        }
        return;
    }
    int g = 0;
#pragma unroll
    for (int v = 0; v < NV; ++v) g += __popcll(__ballot(k[v] > T));
    const int need = 16 - g;
    int ebase = 0, pbase = 0;
#pragma unroll
    for (int v = 0; v < NV; ++v) {
        const unsigned long long e = __ballot(k[v] == T);
        const int pe = ebase + mbcnt64(e);
        keep[v] = (k[v] > T) || ((k[v] == T) && (pe < need));
        ebase += __popcll(e);
        const unsigned long long K = __ballot(keep[v]);
        pos[v] = pbase + mbcnt64(K);
        pbase += __popcll(K);
    }
}
constexpr int PW_IDX = 0, PW_GATE = 128, PW_USC = 256, PW_VSC = 384, PW_SLOT = 512, PW_WW = 1024, PW_TKF = 1152, PW_TKI = 1216, PW_TR = 1280, PW_SC = 1792, PW_WORDS = 2816;

template <bool SCALES>
__device__ __forceinline__ void peer_select_head(const Params& p, int l, int lane, const float (&sv)[2][2], float* wl, float* sl, int slot) {
    float* tkf = wl + PW_TKF; int* tki = reinterpret_cast<int*>(wl) + PW_TKI;
#pragma unroll
    for (int p2 = 0; p2 < 2; ++p2) {
        const unsigned k[2] = {fkey(sv[p2][0]), fkey(sv[p2][1])};
        bool keep[2]; int pos[2];
        select16<2>(k, keep, pos);
        if (keep[0]) { tkf[p2 * 16 + pos[0]] = sv[p2][0]; tki[p2 * 16 + pos[0]] = lane; }
        if (keep[1]) { tkf[p2 * 16 + pos[1]] = sv[p2][1]; tki[p2 * 16 + pos[1]] = lane + 64; }
    }
    wave_lds_fence();
    const int i = lane >> 2, jb = (lane & 3) * 4;
    const float a = tkf[i];
    float c[4]; unsigned ck[4];
#pragma unroll
    for (int k = 0; k < 4; ++k) { c[k] = a + tkf[16 + jb + k]; ck[k] = fkey(c[k]); }
    bool keep4[4]; int pos4[4];
    select16<4>(ck, keep4, pos4);
    const int ia = tki[i];
#pragma unroll
    for (int k = 0; k < 4; ++k) if (keep4[k]) { tkf[32 + pos4[k]] = c[k]; tki[32 + pos4[k]] = ia * 128 + tki[16 + jb + k]; }
    wave_lds_fence();
    const float best = (lane < 16) ? tkf[32 + lane] : -3.0e38f;
    const float mx = wave_max(best);
    const float ex = (lane < 16) ? __expf(best - mx) : 0.f;
    const float sm = wave_sum(ex);
    if (lane < 16) {
        const int ei = tki[32 + lane];
        reinterpret_cast<int*>(sl)[PW_IDX + slot * 16 + lane] = ei;
        sl[PW_GATE + slot * 16 + lane] = ex / sm;
        if (SCALES && PEER_U_FMT != 4) sl[PW_USC + slot * 16 + lane] = p.Usc[l * NEXP + ei];
        if (SCALES && PEER_V_FMT != 4) sl[PW_VSC + slot * 16 + lane] = p.Vsc[l * NEXP + ei];
    }
    wave_lds_fence();
}

template <int F> struct RowFmt;
template <> struct RowFmt<8> {
    static constexpr int ROWB = 2048, NB = 8;
    struct Regs { uint4 a, b; };
    static __device__ __forceinline__ int col(int lane, int m) { return (m >> 3) * 1024 + lane * 16 + (m & 7) * 2; }
    static __device__ __forceinline__ Regs load(const unsigned char* row, int lane) {
        Regs r; r.a = *reinterpret_cast<const uint4*>(row + lane * 16); r.b = *reinterpret_cast<const uint4*>(row + 1024 + lane * 16); return r;
    }
    static __device__ __forceinline__ void pin(Regs& r) {
        asm volatile("" : "+v"(r.a.x), "+v"(r.a.y), "+v"(r.a.z), "+v"(r.a.w), "+v"(r.b.x), "+v"(r.b.y), "+v"(r.b.z), "+v"(r.b.w));
    }
    template <class FN> static __device__ __forceinline__ void foreach(const Regs& r, FN&& fn) {
        const unsigned d[8] = {r.a.x, r.a.y, r.a.z, r.a.w, r.b.x, r.b.y, r.b.z, r.b.w};
#pragma unroll
        for (int w = 0; w < 8; ++w) {
            fn(w * 2, __builtin_amdgcn_cvt_pk_f32_fp8((int)d[w], false));
            fn(w * 2 + 1, __builtin_amdgcn_cvt_pk_f32_fp8((int)d[w], true));
        }
    }
};
template <> struct RowFmt<4> {
    static constexpr int ROWB = 1088, NB = 16;
    struct Regs { uint4 a; unsigned sc; };
    static __device__ __forceinline__ int col(int lane, int m) { return lane * 32 + m * 2; }
    static __device__ __forceinline__ Regs load(const unsigned char* row, int lane) {
        Regs r; r.a = *reinterpret_cast<const uint4*>(row + lane * 16); r.sc = row[1024 + lane]; return r;
    }
    static __device__ __forceinline__ void pin(Regs& r) {
        asm volatile("" : "+v"(r.a.x), "+v"(r.a.y), "+v"(r.a.z), "+v"(r.a.w), "+v"(r.sc));
    }
    template <class FN> static __device__ __forceinline__ void foreach(const Regs& r, FN&& fn) {
        const unsigned d[4] = {r.a.x, r.a.y, r.a.z, r.a.w};
        const float s = __uint_as_float(r.sc << 23);
#pragma unroll
        for (int w = 0; w < 4; ++w) {
            fn(w * 4 + 0, __builtin_amdgcn_cvt_scalef32_pk_f32_fp4(d[w], s, 0));
            fn(w * 4 + 1, __builtin_amdgcn_cvt_scalef32_pk_f32_fp4(d[w], s, 1));
            fn(w * 4 + 2, __builtin_amdgcn_cvt_scalef32_pk_f32_fp4(d[w], s, 2));
            fn(w * 4 + 3, __builtin_amdgcn_cvt_scalef32_pk_f32_fp4(d[w], s, 3));
        }
    }
};
template <> struct RowFmt<5> {
    static constexpr int ROWB = 1024, NB = 16;
    struct Regs { uint4 a; };
    static __device__ __forceinline__ int col(int lane, int m) { return lane * 32 + m * 2; }
    static __device__ __forceinline__ Regs load(const unsigned char* row, int lane) {
        Regs r; r.a = *reinterpret_cast<const uint4*>(row + lane * 16); return r;
    }
    static __device__ __forceinline__ void pin(Regs& r) { asm volatile("" : "+v"(r.a.x), "+v"(r.a.y), "+v"(r.a.z), "+v"(r.a.w)); }
    template <class FN> static __device__ __forceinline__ void foreach(const Regs& r, FN&& fn) {
        const unsigned d[4] = {r.a.x, r.a.y, r.a.z, r.a.w};
#pragma unroll
        for (int w = 0; w < 4; ++w) {
            fn(w * 4 + 0, __builtin_amdgcn_cvt_scalef32_pk_f32_fp4(d[w], 1.0f, 0));
            fn(w * 4 + 1, __builtin_amdgcn_cvt_scalef32_pk_f32_fp4(d[w], 1.0f, 1));
            fn(w * 4 + 2, __builtin_amdgcn_cvt_scalef32_pk_f32_fp4(d[w], 1.0f, 2));
            fn(w * 4 + 3, __builtin_amdgcn_cvt_scalef32_pk_f32_fp4(d[w], 1.0f, 3));
        }
    }
    template <class FN> static __device__ __forceinline__ void foreach_h(const Regs& r, FN&& fn) {
        const unsigned d[4] = {r.a.x, r.a.y, r.a.z, r.a.w};
#pragma unroll
        for (int w = 0; w < 4; ++w) {
            fn(w * 4 + 0, __builtin_amdgcn_cvt_scalef32_pk_f16_fp4(d[w], 1.0f, 0));
            fn(w * 4 + 1, __builtin_amdgcn_cvt_scalef32_pk_f16_fp4(d[w], 1.0f, 1));
            fn(w * 4 + 2, __builtin_amdgcn_cvt_scalef32_pk_f16_fp4(d[w], 1.0f, 2));
            fn(w * 4 + 3, __builtin_amdgcn_cvt_scalef32_pk_f16_fp4(d[w], 1.0f, 3));
        }
    }
};
template <int F>
__device__ __forceinline__ void peer_load_vec(const Params& p, int l, int t, int lane, float2v (&x2)[16]) {
    const bf16_t* z = p.X1bf + (long)t * DM;
    const float* g = p.ln1_g + l * DM; const float* bb = p.ln1_b + l * DM;
    uint2 zr[8]; float4 gg[8], be[8];
#pragma unroll
    for (int q = 0; q < 8; ++q) {
        const int c = RowFmt<F>::col(lane, 2 * q);
        zr[q] = *reinterpret_cast<const uint2*>(z + c);
        gg[q] = *reinterpret_cast<const float4*>(g + c);
        be[q] = *reinterpret_cast<const float4*>(bb + c);
    }
    float s1 = 0.f, s2 = 0.f;
    if (t < TPROMPT) {
#pragma unroll
        for (int q = 0; q < 8; ++q) { const float2 pq = *reinterpret_cast<const float2*>(p.ZS + (((long)l * TPROMPT + t) * 8 + q) * 2); s1 += pq.x; s2 += pq.y; }
    } else {
#pragma unroll
        for (int q = 0; q < 8; ++q) {
            const float f0 = __uint_as_float(zr[q].x << 16), f1 = __uint_as_float(zr[q].x & 0xffff0000u);
            const float f2 = __uint_as_float(zr[q].y << 16), f3 = __uint_as_float(zr[q].y & 0xffff0000u);
            s1 += (f0 + f1) + (f2 + f3); s2 += (f0 * f0 + f1 * f1) + (f2 * f2 + f3 * f3);
        }
        s1 = wave_sum(s1); s2 = wave_sum(s2);
    }
    const float mean = s1 * (1.f / DM), rstd = rsqrtf(fmaxf(s2 * (1.f / DM) - mean * mean, 0.f) + 1e-5f);
#pragma unroll
    for (int q = 0; q < 8; ++q) {
        const float4 a = make_float4(__uint_as_float(zr[q].x << 16), __uint_as_float(zr[q].x & 0xffff0000u), __uint_as_float(zr[q].y << 16), __uint_as_float(zr[q].y & 0xffff0000u));
        x2[2 * q] = float2v{(a.x - mean) * rstd * gg[q].x + be[q].x, (a.y - mean) * rstd * gg[q].y + be[q].y};
        x2[2 * q + 1] = float2v{(a.z - mean) * rstd * gg[q].z + be[q].z, (a.w - mean) * rstd * gg[q].w + be[q].w};
    }
}

template <int NE, class HOOK>
__device__ __forceinline__ void peer_gather(const Params& p, int l, int lane, float* wl, const float* sl, const float2v (&x2)[16], float2v (&acc)[16], half2v (&x2h)[16], HOOK&& hook) {
    static_assert(PEER_U_FMT == PEER_V_FMT, "pipelined gather assumes one row format");
    using FU = RowFmt<PEER_U_FMT>; using FV = RowFmt<PEER_V_FMT>;
    typedef typename FU::Regs Regs;
    const int* idx = reinterpret_cast<const int*>(sl) + PW_IDX;
    const float* gate = sl + PW_GATE; const float* usc = sl + PW_USC; const float* vsc = sl + PW_VSC; float* ww = wl + PW_WW;
    float* tr = wl + PW_TR;
    const unsigned char* Ul = p.U8 + (long)l * NEXP * FU::ROWB;
    const unsigned char* Vl = p.V8 + (long)l * NEXP * FV::ROWB;
    constexpr int NB = FU::NB / 2, NBAT = NE / NB, NR = 2 * NB;
    Regs bufA[NB], bufB[NB];
#if PEER_F16
    half2v acch[16];
#pragma unroll
    for (int m = 0; m < 16; ++m) {
        x2h[m] = __builtin_convertvector(x2[m], half2v);
        unsigned xr = __builtin_bit_cast(unsigned, x2h[m]); asm volatile("" : "+v"(xr)); x2h[m] = __builtin_bit_cast(half2v, xr);
        acch[m] = half2v{(_Float16)0.f, (_Float16)0.f};
    }
    float wscale = 1.f;
#endif
    auto load = [&](Regs (&buf)[NB], const unsigned char* tab, int k0) {
#pragma unroll
        for (int e = 0; e < NB; ++e) {
            const int ex = __builtin_amdgcn_readfirstlane(idx[k0 + e]);
            buf[e] = FU::load(tab + (long)ex * FU::ROWB, lane);
        }
    };
    auto compU = [&](Regs (&buf)[NB], int g) {
#pragma unroll
        for (int e = 0; e < NB; ++e) {
            FU::pin(buf[e]);
#if PEER_F16
            float sa = 0.f, sb = 0.f;
            FU::foreach_h(buf[e], [&](int m, half2v f) { if (m & 1) sb = __builtin_amdgcn_fdot2(f, x2h[m], sb, false); else sa = __builtin_amdgcn_fdot2(f, x2h[m], sa, false); });
            tr[((g & 1) * NB + e) * 65 + lane] = sa + sb;
#else
            float2v s2 = {0.f, 0.f};
            FU::foreach(buf[e], [&](int m, float2v f) { s2 = f * x2[m] + s2; });
            tr[((g & 1) * NB + e) * 65 + lane] = s2.x + s2.y;
#endif
            __builtin_amdgcn_sched_barrier(0);
        }
        if (g & 1) {
            wave_lds_fence();
            const int k0 = (g - 1) * NB;
            const int e = lane & (NR - 1), seg = lane / NR;
            float hs = 0.f;
#pragma unroll
            for (int i = 0; i < NR; ++i) hs += tr[e * 65 + seg * NR + i];
#pragma unroll
            for (int d = NR; d < 64; d <<= 1) hs += __shfl_xor(hs, d);
            if (PEER_U_FMT != 4) hs *= usc[k0 + e];
            float wv = gate[k0 + e] * geluf_(hs);
            if (PEER_V_FMT != 4) wv *= vsc[k0 + e];
            if (seg == 0) ww[k0 + e] = wv;
            wave_lds_fence();
        }
    };
    auto compV = [&](Regs (&buf)[NB], int g) {
        const int k0 = g * NB;
#pragma unroll
        for (int e = 0; e < NB; ++e) {
            FV::pin(buf[e]);
#if PEER_F16
            const _Float16 wh = (_Float16)(ww[k0 + e] * wscale);
            const half2v w2 = {wh, wh};
            FV::foreach_h(buf[e], [&](int m, half2v f) { acch[m] = f * w2 + acch[m]; });
#else
            const float wv = ww[k0 + e];
            const float2v w2 = {wv, wv};
            FV::foreach(buf[e], [&](int m, float2v f) { acc[m] = f * w2 + acc[m]; });
#endif
            __builtin_amdgcn_sched_barrier(0);
        }
    };
    Regs bufC[NB];
#define PG_SB __builtin_amdgcn_sched_barrier(0)
#if PEER_F16
#define PEER_WSCALE() do { float wm = (NE == 128) ? fmaxf(fabsf(ww[lane]), fabsf(ww[lane + 64])) : ((lane < NE) ? fabsf(ww[lane & (NE - 1)]) : 0.f); wm = wave_max(wm); \
                           wscale = wm > 0.f ? 64.f / wm : 1.f; } while (0)
#else
#define PEER_WSCALE() do { } while (0)
#endif
#if PEER_MFMA_U
    {
        typedef int int8v __attribute__((ext_vector_type(8)));
        unsigned char* xq = reinterpret_cast<unsigned char*>(wl + PW_TR);
        float am = 0.f;
#pragma unroll
        for (int m = 0; m < 16; ++m) am = fmaxf(am, fmaxf(fabsf(x2[m].x), fabsf(x2[m].y)));
        am = wave_max(am);
        const float sx = am > 0.f ? 6.f / am : 1.f, isx = 1.f / sx;
        {
            unsigned q1[4], q2[4];
#pragma unroll
            for (int d = 0; d < 4; ++d) {
                unsigned p1 = 0u, p2 = 0u;
#define XQ_STEP(bs) do { const float a0 = x2[d * 4 + bs].x * sx, a1 = x2[d * 4 + bs].y * sx; \
                    p1 = __builtin_amdgcn_cvt_scalef32_pk_fp4_f32(p1, a0, a1, 1.0f, bs); \
                    const float2v back = __builtin_amdgcn_cvt_scalef32_pk_f32_fp4(p1, 1.0f, bs); \
                    p2 = __builtin_amdgcn_cvt_scalef32_pk_fp4_f32(p2, (a0 - back.x) * 6.f, (a1 - back.y) * 6.f, 1.0f, bs); } while (0)
                XQ_STEP(0); XQ_STEP(1); XQ_STEP(2); XQ_STEP(3);
#undef XQ_STEP
                q1[d] = p1; q2[d] = p2;
            }
            *reinterpret_cast<uint4*>(xq + lane * 16) = make_uint4(q1[0], q1[1], q1[2], q1[3]);
            *reinterpret_cast<uint4*>(xq + 1024 + lane * 16) = make_uint4(q2[0], q2[1], q2[2], q2[3]);
        }
        wave_lds_fence();
        const int ri = lane & 15, kq = lane >> 4;
        constexpr int NG = NE / 16;
        uint4 ga[16], gb[16];
        auto gload = [&](uint4 (&buf)[16], int g) {
            const unsigned char* row = Ul + (long)idx[g * 16 + ri] * FU::ROWB + kq * 16;
#pragma unroll
            for (int s_ = 0; s_ < 16; ++s_) buf[s_] = *reinterpret_cast<const uint4*>(row + s_ * 64);
        };
        const int bsel = (ri == 1) ? 1024 : 0;
        auto gepi = [&](const f32x4& a4, int g) {
#pragma unroll
            for (int rg = 0; rg < 4; ++rg) {
                const int e = g * 16 + kq * 4 + rg;
                const float lo = dpp_mov<0xF5>(a4[rg]);
                float hs = (a4[rg] + lo * (1.f / 6.f)) * isx;
                if (PEER_U_FMT != 4) hs *= usc[e];
                float wv = gate[e] * geluf_(hs);
                if (PEER_V_FMT != 4) wv *= vsc[e];
                if (ri == 0) ww[e] = wv;
            }
        };
        auto gcomp2 = [&](uint4 (&bA)[16], uint4 (&bB)[16], int g) {
            uint4 bf[16];
#pragma unroll
            for (int s_ = 0; s_ < 16; ++s_) bf[s_] = *reinterpret_cast<const uint4*>(xq + bsel + s_ * 64 + kq * 16);
            f32x4 accA = f32x4{0.f, 0.f, 0.f, 0.f}, accB = f32x4{0.f, 0.f, 0.f, 0.f};
#pragma unroll
            for (int s_ = 0; s_ < 16; ++s_) {
                const int8v Bv = {(int)bf[s_].x, (int)bf[s_].y, (int)bf[s_].z, (int)bf[s_].w, 0, 0, 0, 0};
                const int8v A0 = {(int)bA[s_].x, (int)bA[s_].y, (int)bA[s_].z, (int)bA[s_].w, 0, 0, 0, 0};
                accA = __builtin_amdgcn_mfma_scale_f32_16x16x128_f8f6f4(A0, Bv, accA, 4, 4, 0, 127, 0, 127);
                if (NG > 1) {
                    const int8v A1 = {(int)bB[s_].x, (int)bB[s_].y, (int)bB[s_].z, (int)bB[s_].w, 0, 0, 0, 0};
                    accB = __builtin_amdgcn_mfma_scale_f32_16x16x128_f8f6f4(A1, Bv, accB, 4, 4, 0, 127, 0, 127);
                }
            }
            gepi(accA, g);
            if (NG > 1) gepi(accB, g + 1);
        };
#pragma unroll 1
        for (int g = 0; g < NG; g += 2) {
            gload(ga, g); if (NG > 1) gload(gb, g + 1);
            PG_SB; if (NE == 128) { hook(g >> 1); PG_SB; } else { hook(0); PG_SB; }
            gcomp2(ga, gb, g); PG_SB;
        }
        wave_lds_fence();
    }
    {
        Regs bufD[NB];
        PEER_WSCALE();
        if (NBAT == 16) {
#pragma unroll 1
            for (int G = 0; G < 16; G += 4) {
                load(bufA, Vl, G * NB); load(bufB, Vl, (G + 1) * NB); load(bufC, Vl, (G + 2) * NB); load(bufD, Vl, (G + 3) * NB);
                PG_SB; hook(4 + (G >> 2)); PG_SB;
                compV(bufA, G); PG_SB; compV(bufB, G + 1); PG_SB; compV(bufC, G + 2); PG_SB; compV(bufD, G + 3); PG_SB;
            }
        } else {
            load(bufA, Vl, 0); load(bufB, Vl, NB); PG_SB;
            hook(1); PG_SB;
            compV(bufA, 0); PG_SB; compV(bufB, 1); PG_SB;
        }
    }
#else
    auto loadG = [&](Regs (&buf)[NB], int G) {
        if (G < NBAT) load(buf, Ul, G * NB); else if (G < 2 * NBAT) load(buf, Vl, (G - NBAT) * NB);
    };
#define PG_U(buf, nxt, G) do { loadG(nxt, (G) + 2); PG_SB; compU(buf, (G)); PG_SB; } while (0)
#define PG_V(buf, nxt, G) do { loadG(nxt, (G) + 2); PG_SB; compV(buf, (G) - NBAT); PG_SB; } while (0)
    if (NBAT == 16) {
        loadG(bufA, 0); loadG(bufB, 1); PG_SB;
#pragma unroll 1
        for (int G = 0; G < 15; G += 3) { PG_U(bufA, bufC, G); PG_U(bufB, bufA, G + 1); PG_U(bufC, bufB, G + 2); }
        PG_U(bufA, bufC, 15);
        PEER_WSCALE();
        PG_V(bufB, bufA, 16); PG_V(bufC, bufB, 17);
#pragma unroll 1
        for (int G = 18; G < 30; G += 3) { PG_V(bufA, bufC, G); PG_V(bufB, bufA, G + 1); PG_V(bufC, bufB, G + 2); }
        PG_V(bufA, bufC, 30); PG_V(bufB, bufA, 31);
    } else {
        loadG(bufA, 0); loadG(bufB, 1); PG_SB;
        PG_U(bufA, bufC, 0); PG_U(bufB, bufA, 1); PEER_WSCALE(); PG_V(bufC, bufB, 2); PG_V(bufA, bufC, 3);
    }
#undef PG_U
#undef PG_V
#endif
#undef PG_SB
#undef PEER_WSCALE
#if PEER_F16
    {
        const float inv = 1.f / wscale;
#pragma unroll
        for (int m = 0; m < 16; ++m) acc[m] = float2v{(float)acch[m].x * inv, (float)acch[m].y * inv};
    }
#endif
}
__device__ __forceinline__ float* peer_out_row(const Params& p, int l, int t) {
    if (l == 3) return (t < TPROMPT) ? (p.out + O_YP + (long)t * DM) : (p.out + O_YS + (long)(t - TPROMPT) * DM);
    return p.out;
}
__device__ __forceinline__ void peer_stage_scores(const Params& p, int t, float* wl) {
    const int lane = otid() & 63;
    const uint4* src = reinterpret_cast<const uint4*>(reinterpret_cast<const bf16_t*>(p.SC) + (long)t * DM);
    const uint4 v0 = src[lane], v1 = src[64 + lane], v2 = src[128 + lane], v3 = src[192 + lane];
    __builtin_amdgcn_sched_barrier(0);
    uint4* dst = reinterpret_cast<uint4*>(wl + PW_SC);
    dst[lane] = v0; dst[64 + lane] = v1; dst[128 + lane] = v2; dst[192 + lane] = v3;
    wave_lds_fence();
}
__device__ __forceinline__ void peer_select_slice(const Params& p, int l, float* wl, float* sl, int h) {
    const int lane = otid() & 63;
    const bf16_t* scl = reinterpret_cast<const bf16_t*>(wl + PW_SC);
    float sv[2][2];
#pragma unroll
    for (int p2 = 0; p2 < 2; ++p2) { sv[p2][0] = bf2f(scl[(h * 2 + p2) * 128 + lane]); sv[p2][1] = bf2f(scl[(h * 2 + p2) * 128 + 64 + lane]); }
    peer_select_head<false>(p, l, lane, sv, wl, sl, h);
}
template <class HOOK>
__device__ __forceinline__ void peer_token_gather(const Params& p, int l, int t, int tn, float* wl, float* sl, HOOK&& hook) {
    using FV = RowFmt<PEER_V_FMT>;
    const int lane = otid() & 63;
    const int ei0 = reinterpret_cast<const int*>(sl)[PW_IDX + lane], ei1 = reinterpret_cast<const int*>(sl)[PW_IDX + 64 + lane];
    const float us0 = p.Usc[l * NEXP + ei0], vs0 = p.Vsc[l * NEXP + ei0], us1 = p.Usc[l * NEXP + ei1], vs1 = p.Vsc[l * NEXP + ei1];
    const uint4* scsrc = reinterpret_cast<const uint4*>(reinterpret_cast<const bf16_t*>(p.SC) + (long)(tn >= 0 ? tn : t) * DM);
    const uint4 scv0 = scsrc[lane], scv1 = scsrc[64 + lane], scv2 = scsrc[128 + lane], scv3 = scsrc[192 + lane];
    float2v x2[16], acc[16];
    peer_load_vec<PEER_U_FMT>(p, l, t, lane, x2);
    sl[PW_USC + lane] = us0; sl[PW_VSC + lane] = vs0; sl[PW_USC + 64 + lane] = us1; sl[PW_VSC + 64 + lane] = vs1;
    { uint4* scd = reinterpret_cast<uint4*>(wl + PW_SC); scd[lane] = scv0; scd[64 + lane] = scv1; scd[128 + lane] = scv2; scd[192 + lane] = scv3; }
#pragma unroll
    for (int i = 0; i < 16; ++i) acc[i] = float2v{0.f, 0.f};
    wave_lds_fence();
    half2v xh[16];
    peer_gather<128>(p, l, lane, wl, sl, x2, acc, xh, hook);
    if (PEER_U_FMT != PEER_V_FMT) peer_load_vec<PEER_V_FMT>(p, l, t, lane, x2);
    const float* g = p.ln2_g + l * DM; const float* bb = p.ln2_b + l * DM;
    float4 g2v[8], b2v[8];
#pragma unroll
    for (int q8 = 0; q8 < 4; ++q8)
#pragma unroll
        for (int hf = 0; hf < 2; ++hf) {
            const int col = FV::col(lane, 4 * q8);
            g2v[q8 * 2 + hf] = *reinterpret_cast<const float4*>(g + col + hf * 4);
            b2v[q8 * 2 + hf] = *reinterpret_cast<const float4*>(bb + col + hf * 4);
        }
    float s = 0.f;
#pragma unroll
    for (int i = 0; i < 16; ++i) { acc[i] = float2v{(float)xh[i].x, (float)xh[i].y} * float2v{ALPHA_F, ALPHA_F} + acc[i]; s += acc[i].x + acc[i].y; }
    const float mean = wave_sum(s) * (1.f / DM);
    float q = 0.f;
#pragma unroll
    for (int i = 0; i < 16; ++i) { const float d0 = acc[i].x - mean, d1 = acc[i].y - mean; q += d0 * d0 + d1 * d1; }
    const float rstd = rsqrtf(wave_sum(q) * (1.f / DM) + 1e-5f);
    float* yo = peer_out_row(p, l, t);
#pragma unroll
    for (int q8 = 0; q8 < 4; ++q8) {
        const int col = FV::col(lane, 4 * q8);
        float y[8];
#pragma unroll
        for (int hf = 0; hf < 2; ++hf) {
            const float4 gg = g2v[q8 * 2 + hf];
            const float4 be = b2v[q8 * 2 + hf];
            y[hf * 4 + 0] = (acc[4 * q8 + 2 * hf].x - mean) * rstd * gg.x + be.x;
            y[hf * 4 + 1] = (acc[4 * q8 + 2 * hf].y - mean) * rstd * gg.y + be.y;
            y[hf * 4 + 2] = (acc[4 * q8 + 2 * hf + 1].x - mean) * rstd * gg.z + be.z;
            y[hf * 4 + 3] = (acc[4 * q8 + 2 * hf + 1].y - mean) * rstd * gg.w + be.w;
            if (l == 3) *reinterpret_cast<float4*>(yo + col + hf * 4) = make_float4(y[hf * 4], y[hf * 4 + 1], y[hf * 4 + 2], y[hf * 4 + 3]);
        }
        if (l < 3) *reinterpret_cast<uint4*>(p.Xbf + (long)t * DM + col) = pack8(y);
    }
    wave_lds_fence();
}
template <class HOOK>
__device__ __forceinline__ void peer_token_block(const Params& p, int l, int t, float* wl, float* red  , float* stat  , HOOK&& hook) {
    const int tid = otid(), lane = tid & 63, w = __builtin_amdgcn_readfirstlane(tid >> 6);
    float sv[2][2];
    {
        float* scs = wl + PW_TR;
        const bf16_t* qrow = p.Q + (long)t * DM + w * 256;
        const int r = lane & 15, q4 = lane >> 4;
#pragma unroll
        for (int p2 = 0; p2 < 2; ++p2) {
            const bf16_t* kb = p.keys + (((long)l * 16 + w * 2 + p2) * 128 + r) * 128 + q4 * 8;
            bf16x8 kfr[8][4], qfr[4];
#pragma unroll
            for (int ks = 0; ks < 4; ++ks) qfr[ks] = *reinterpret_cast<const bf16x8*>(qrow + p2 * 128 + ks * 32 + q4 * 8);
#pragma unroll
            for (int tt = 0; tt < 8; ++tt)
#pragma unroll
                for (int ks = 0; ks < 4; ++ks) kfr[tt][ks] = *reinterpret_cast<const bf16x8*>(kb + (long)tt * 16 * 128 + ks * 32);
            __builtin_amdgcn_sched_barrier(0);
            hook(2 * p2); hook(2 * p2 + 1);
            __builtin_amdgcn_sched_barrier(0);
#pragma unroll
            for (int tt = 0; tt < 8; ++tt) {
                f32x4 a4 = f32x4{0.f, 0.f, 0.f, 0.f};
#pragma unroll
                for (int ks = 0; ks < 4; ++ks) a4 = mfma16(kfr[tt][ks], qfr[ks], a4);
                if (r == 0) *reinterpret_cast<f32x4*>(scs + tt * 16 + q4 * 4) = a4;
            }
            wave_lds_fence();
            sv[p2][0] = scs[lane]; sv[p2][1] = scs[lane + 64];
            wave_lds_fence();
        }
    }
    float* slb = wl + PW_SLOT;
    peer_select_head<true>(p, l, lane, sv, wl, slb, 0);
    float2v x2[16], acc[16];
    peer_load_vec<PEER_U_FMT>(p, l, t, lane, x2);
#pragma unroll
    for (int i = 0; i < 16; ++i) acc[i] = float2v{0.f, 0.f};
    half2v xh[16];
    peer_gather<16>(p, l, lane, wl, slb, x2, acc, xh, [&](int k) { hook(4 + k); });
#pragma unroll
    for (int m = 0; m < 16; ++m) *reinterpret_cast<float2v*>(red + w * DM + RowFmt<PEER_V_FMT>::col(lane, m)) = acc[m];
    __syncthreads();
    const int col = tid * 4;
    float4 xv;
    {
        const uint2 zq = *reinterpret_cast<const uint2*>(p.X1bf + (long)t * DM + col);
        const float4 zz = make_float4(__uint_as_float(zq.x << 16), __uint_as_float(zq.x & 0xffff0000u), __uint_as_float(zq.y << 16), __uint_as_float(zq.y & 0xffff0000u));
        const float4 g1 = *reinterpret_cast<const float4*>(p.ln1_g + l * DM + col), b1 = *reinterpret_cast<const float4*>(p.ln1_b + l * DM + col);
        __builtin_amdgcn_sched_barrier(0);
        hook(6); hook(7);
        __builtin_amdgcn_sched_barrier(0);
        const float ps1 = wave_sum(zz.x + zz.y + zz.z + zz.w), ps2 = wave_sum(zz.x * zz.x + zz.y * zz.y + zz.z * zz.z + zz.w * zz.w);
        if (lane == 0) { stat[16 + w] = ps1; stat[24 + w] = ps2; }
        __syncthreads();
        float s1 = 0.f, s2 = 0.f;
#pragma unroll
        for (int i = 0; i < 8; ++i) { s1 += stat[16 + i]; s2 += stat[24 + i]; }
        const float mean1 = s1 * (1.f / DM), rstd1 = rsqrtf(fmaxf(s2 * (1.f / DM) - mean1 * mean1, 0.f) + 1e-5f);
        xv.x = (zz.x - mean1) * rstd1 * g1.x + b1.x; xv.y = (zz.y - mean1) * rstd1 * g1.y + b1.y;
        xv.z = (zz.z - mean1) * rstd1 * g1.z + b1.z; xv.w = (zz.w - mean1) * rstd1 * g1.w + b1.w;
    }
    float z0 = ALPHA_F * xv.x, z1 = ALPHA_F * xv.y, z2 = ALPHA_F * xv.z, z3 = ALPHA_F * xv.w;
#pragma unroll
    for (int ww_ = 0; ww_ < 8; ++ww_) {
        const float4 r = *reinterpret_cast<const float4*>(red + ww_ * DM + col);
        z0 += r.x; z1 += r.y; z2 += r.z; z3 += r.w;
    }
    const float ps = wave_sum(z0 + z1 + z2 + z3);
    if (lane == 0) stat[w] = ps;
    __syncthreads();
    float tot = 0.f;
#pragma unroll
    for (int i = 0; i < 8; ++i) tot += stat[i];
    const float mean = tot * (1.f / DM);
    const float d0 = z0 - mean, d1 = z1 - mean, d2 = z2 - mean, d3 = z3 - mean;
    const float pq = wave_sum(d0 * d0 + d1 * d1 + d2 * d2 + d3 * d3);
    if (lane == 0) stat[8 + w] = pq;
    __syncthreads();
    float totq = 0.f;
#pragma unroll
    for (int i = 0; i < 8; ++i) totq += stat[8 + i];
    const float rstd = rsqrtf(totq * (1.f / DM) + 1e-5f);
    const float4 gg = *reinterpret_cast<const float4*>(p.ln2_g + l * DM + col);
    const float4 be = *reinterpret_cast<const float4*>(p.ln2_b + l * DM + col);
    const float y0 = d0 * rstd * gg.x + be.x, y1 = d1 * rstd * gg.y + be.y, y2 = d2 * rstd * gg.z + be.z, y3 = d3 * rstd * gg.w + be.w;
    float* yo = peer_out_row(p, l, t);
    if (l == 3) *reinterpret_cast<float4*>(yo + col) = make_float4(y0, y1, y2, y3);
    if (l < 3) { uint2 pk; pk.x = pack2(y0, y1); pk.y = pack2(y2, y3); *reinterpret_cast<uint2*>(p.Xbf + (long)t * DM + col) = pk; }
    __syncthreads();
}
__device__ __forceinline__ void ph_peer(const Params& p, int l) {
    extern __shared__ __attribute__((aligned(16))) char smem[];
    const int w = __builtin_amdgcn_readfirstlane(otid() >> 6);
    float* wl = reinterpret_cast<float*>(smem) + w * PW_WORDS;
    float* red = reinterpret_cast<float*>(smem) + 8 * PW_WORDS;
    float* stat = red + 8 * DM;
    bool presel = false;
    for (int s = blockIdx.x; s < TSAMP; s += gridDim.x) {
        const int t0 = blockIdx.x * 8 + w;
        const bool first = (s == (int)blockIdx.x) && (t0 < TPROMPT);
        if (first) peer_stage_scores(p, t0, wl);
        peer_token_block(p, l, TPROMPT + s, wl, red, stat, [&](int k) { if (first) peer_select_slice(p, l, wl, wl, k); });
        presel = presel || first;
    }
    const int tstride = gridDim.x * 8;
    int t = blockIdx.x * 8 + w;
    if (t < TPROMPT) {
        if (!presel) {
            peer_stage_scores(p, t, wl);
#pragma unroll 1
            for (int h = 0; h < 8; ++h) peer_select_slice(p, l, wl, wl, h);
        }
        int cur = 0;
#pragma unroll 1
        for (; t < TPROMPT; t += tstride) {
            const int tn = t + tstride;
            const bool has_next = tn < TPROMPT;
            float* slc = wl + cur * PW_SLOT; float* sln = wl + (cur ^ 1) * PW_SLOT;
            peer_token_gather(p, l, t, has_next ? tn : -1, wl, slc, [&](int k) { if (has_next) peer_select_slice(p, l, wl, sln, k); });
            cur ^= 1;
        }
    }
}

enum { PH_PRO = 0, PH_GEMM1, PH_MIXA, PH_SCAN, PH_MIXB, PH_GEMM2, PH_GEMM3, PH_PEER };

template <int PH>
__device__ __forceinline__ void run_phase(const Params& p, int l) {
    if (PH == PH_PRO) ph_prologue(p);
    else if (PH == PH_GEMM1) {
        gemm_phase<EPI_PROJ>(p.Xbf, p.wt_in + (long)l * NINP * DM, TPROMPT, NINP, DM, p.PROJ, nullptr, nullptr, 0.f,
                             ProjEpi{p.rope_cos, p.rope_sin, p.lb_logits, p.gla_wa2, p.gla_ba, p.out, l, nullptr, nullptr, nullptr, nullptr, nullptr, nullptr});
        if (l < 3) {
            const int ntile = (TPROMPT / BM) * (NINP / BM), fl = ntile % (int)gridDim.x, nb = (int)gridDim.x - fl;
            transpose_conv(p.w_in, DM, NIN, NINP, p.wt_in, l + 1, 1, fl, nb);
            transpose_conv(p.w_out, DM, DM, DM, p.wt_out, l + 1, 1, fl, nb);
            transpose_conv(p.peer_wq, DM, DM, DM, p.wt_q, l + 1, 1, fl, nb, p.ln1_g, p.ln1_b, p.CP1, p.CP2);
        }
    }
    else if (PH == PH_MIXA) ph_mix_a(p, l);
    else if (PH == PH_SCAN) ph_scan(p, l);
    else if (PH == PH_MIXB) ph_mix_b(p, l);
    else if (PH == PH_GEMM2) gemm_phase<EPI_RESID>(p.OCAT, p.wt_out + (long)l * DM * DM, TPROMPT, DM, DM, p.X1bf, nullptr, p.Xbf, ALPHA_F,
                                                       ProjEpi{nullptr, nullptr, nullptr, nullptr, nullptr, nullptr, l, nullptr, p.ZS + (long)l * TPROMPT * 16, nullptr, nullptr, nullptr, nullptr});
    else if (PH == PH_GEMM3) gemm_phase<EPI_SCORES>(p.X1bf, p.wt_q + (long)l * DM * DM, TPROMPT, DM, DM, p.Q, p.SC, nullptr, 0.f,
                                                        ProjEpi{nullptr, nullptr, nullptr, nullptr, nullptr, nullptr, l, p.keys + (long)l * 16 * 128 * 128,
                                                                p.ZS + (long)l * TPROMPT * 16, p.C1 + l * DM, p.C2 + l * DM, p.X1bf, reinterpret_cast<bf16_t*>(p.SC)});
    else if (PH == PH_PEER) ph_peer(p, l);
}

#if MK_ONE_LAUNCH
__global__ void __launch_bounds__(512, 2) k_mega(Params p) {
    extern __shared__ __attribute__((aligned(16))) char smem[];
    uint4* xbw = reinterpret_cast<uint4*>(smem + LDS_MAIN);
    if (threadIdx.x == 0) *xbw = make_uint4(0u, 0u, 0u, 0u);
    __syncthreads();
    XcdBarrier bar = xcd_barrier_post(p.bar, (volatile LAS unsigned*)xbw);
    for (int rep = 0; rep < REP_PRO; ++rep) { run_phase<PH_PRO>(p, 0); xcd_barrier(bar); }
    for (int l = 0; l < 4; ++l) {
        for (int rep = 0; rep < REP_G1; ++rep) { run_phase<PH_GEMM1>(p, l); xcd_barrier(bar); }
        for (int rep = 0; rep < REP_MIXA; ++rep) { run_phase<PH_MIXA>(p, l); xcd_barrier(bar); }
        run_phase<PH_SCAN>(p, l); xcd_barrier(bar);
        for (int rep = 0; rep < REP_MIXB; ++rep) { run_phase<PH_MIXB>(p, l); xcd_barrier(bar); }
        for (int rep = 0; rep < REP_G2; ++rep) { run_phase<PH_GEMM2>(p, l); xcd_barrier(bar); }
        for (int rep = 0; rep < REP_G3; ++rep) { run_phase<PH_GEMM3>(p, l); xcd_barrier(bar); }
        for (int rep = 0; rep < REP_PEER; ++rep) { run_phase<PH_PEER>(p, l); xcd_barrier(bar); }
    }
}
#endif

#if !MK_ONE_LAUNCH
template <int PH>
__global__ void __launch_bounds__(512, 2) k_phase(Params p, int l) { run_phase<PH>(p, l); }
template <int PH>
static void launch_phase(const Params& p, int l, int grid, hipStream_t stream) {
    static bool attr_set = false;
    if (!attr_set) { (void)hipFuncSetAttribute((const void*)k_phase<PH>, hipFuncAttributeMaxDynamicSharedMemorySize, LDS_BYTES); attr_set = true; }
    hipLaunchKernelGGL(k_phase<PH>, dim3(grid), dim3(NTHREADS), LDS_BYTES, stream, p, l);
}
#endif

extern "C" void kernel_launch(void* const* d_in, const int* in_sizes, int n_in,
                              void* d_out, int out_size, void* d_ws, size_t ws_size,
                              hipStream_t stream) {
    Params p{};
    p.x_prompt = (const float*)d_in[0]; p.x_sample = (const float*)d_in[1]; p.cache_k = (const float*)d_in[2]; p.cache_v = (const float*)d_in[3];
    p.state_hgrn = (const float*)d_in[4]; p.state_gla = (const float*)d_in[5]; p.w_in = (const float*)d_in[6]; p.w_out = (const float*)d_in[7];
    p.sinks = (const float*)d_in[8]; p.hgrn_nw = (const float*)d_in[9]; p.lb_logits = (const float*)d_in[10]; p.gla_wa2 = (const float*)d_in[11];
    p.gla_ba = (const float*)d_in[12]; p.gla_nw = (const float*)d_in[13]; p.ln1_g = (const float*)d_in[14]; p.ln1_b = (const float*)d_in[15];
    p.ln2_g = (const float*)d_in[16]; p.ln2_b = (const float*)d_in[17]; p.peer_wq = (const float*)d_in[18]; p.peer_keys = (const float*)d_in[19];
    p.peer_u = (const float*)d_in[20]; p.peer_v = (const float*)d_in[21];
    p.out = (float*)d_out;
    char* ws = (char*)d_ws;
    size_t off = 0;
    auto take = [&](size_t bytes) { char* r = ws + off; off += (bytes + 255) & ~(size_t)255; return r; };
    p.bar = (unsigned*)take(XCD_BAR_WORDS * 4);
    const size_t zero_bytes = off;
    p.ZS = (float*)take(4UL * TPROMPT * 16 * 4);
    p.C1 = (float*)take(4UL * DM * 4);
    p.C2 = (float*)take(4UL * DM * 4);
    p.CP1 = (float*)take(4UL * 32 * DM * 4);
    p.CP2 = (float*)take(4UL * 32 * DM * 4);
    p.wt_in = (bf16_t*)take(4UL * NINP * DM * 2);
    p.wt_out = (bf16_t*)take(4UL * DM * DM * 2);
    p.wt_q = (bf16_t*)take(4UL * DM * DM * 2);
    p.keys = (bf16_t*)take(4UL * 16 * 128 * 128 * 2);
    p.U8 = (unsigned char*)take(4UL * NEXP * 2048);
    p.V8 = (unsigned char*)take(4UL * NEXP * 2048);
    p.Usc = (float*)take(4UL * NEXP * 4);
    p.Vsc = (float*)take(4UL * NEXP * 4);
    p.rope_cos = (float*)take(2049UL * 32 * 4);
    p.rope_sin = (float*)take(2049UL * 32 * 4);
    p.Xf = (float*)take((size_t)TPAD * DM * 4);
    p.Xbf = (bf16_t*)take((size_t)TPAD * DM * 2);
    p.PROJ = (bf16_t*)take((size_t)TPAD * NINP * 2);
    p.OCAT = (bf16_t*)take((size_t)TPAD * DM * 2);
    p.Z1 = (float*)take((size_t)TPAD * DM * 4);
    p.X1f = (float*)take((size_t)TPAD * DM * 4);
    p.X1bf = (bf16_t*)take((size_t)TPAD * DM * 2);
    p.Q = (bf16_t*)take((size_t)TPAD * DM * 2);
    p.SC = (float*)take((size_t)TPAD * DM * 4);
    p.HST = (bf16_t*)take(16UL * 33 * 128 * 128 * 2);
    p.GST = (bf16_t*)take(16UL * 33 * 64 * 128 * 2);
    p.HD = (float*)take(16UL * 32 * 128 * 4);
    p.GD = (float*)take(16UL * 32 * 64 * 4);
    p.LFC = (bf16_t*)take((size_t)TPROMPT * 256 * 2);

    static int grid = 0;
    if (!grid) {
        int dev = 0, cus = 0;
        (void)hipGetDevice(&dev);
        (void)hipDeviceGetAttribute(&cus, hipDeviceAttributeMultiprocessorCount, dev);
        grid = cus > 0 ? cus : 256;
    }
#if MK_ONE_LAUNCH
    static bool attr_set = false;
    if (!attr_set) {
        (void)hipFuncSetAttribute((const void*)k_mega, hipFuncAttributeMaxDynamicSharedMemorySize, LDS_BYTES);
        int per_cu = 0;
        (void)hipOccupancyMaxActiveBlocksPerMultiprocessor(&per_cu, (const void*)k_mega, NTHREADS, LDS_BYTES);
        if (per_cu < 1) grid = 0;
        attr_set = true;
    }
    if (grid <= 0) return;
    (void)hipMemsetAsync(d_ws, 0, zero_bytes, stream);
    hipLaunchKernelGGL(k_mega, dim3(grid), dim3(NTHREADS), LDS_BYTES, stream, p);
#else
    (void)hipMemsetAsync(d_ws, 0, zero_bytes, stream);
    launch_phase<PH_PRO>(p, 0, grid, stream);
    for (int l = 0; l < 4; ++l) {
        launch_phase<PH_GEMM1>(p, l, grid, stream);
        launch_phase<PH_MIXA>(p, l, grid, stream);
        launch_phase<PH_SCAN>(p, l, grid, stream);
        launch_phase<PH_MIXB>(p, l, grid, stream);
        launch_phase<PH_GEMM2>(p, l, grid, stream);
        launch_phase<PH_GEMM3>(p, l, grid, stream);
        launch_phase<PH_PEER>(p, l, grid, stream);
    }
#endif
}
```
